# Optimizing an MI355X kernel written in HIP

```python
import jax, jax.numpy as jnp
from jax import lax
import numpy as np

D_MODEL = 1024
BATCH = 8
SEQ = 2048
DEPTH = 4
DEC_BATCH = 8
DEC_SEQ = 64
PAST_LEN = 2048

CHUNK = 64
Q_BLOCK = 128
HEAD_DIM = 64
N_HEADS = (3 * D_MODEL // 4) // HEAD_DIM
MIX_WIDTH = N_HEADS * HEAD_DIM
MEM_WIDTH = D_MODEL // 4
N_MEM_HEADS = MEM_WIDTH // HEAD_DIM
N_MEM = 256
D_FF = -(-8 * D_MODEL // (3 * 256)) * 256
N_FOX = (DEPTH + 1) // 2
N_SB = DEPTH // 2
FOX_IN = 3 * MIX_WIDTH + N_HEADS + MEM_WIDTH
SB_IN = 3 * MIX_WIDTH + MEM_WIDTH
EPS = 1e-6
SCALE = HEAD_DIM ** -0.5

kernel_name = "fox_stickbreak_memory_streaming_step"


def rmsnorm(x, g):
    xf = x.astype(jnp.float32)
    y = xf * lax.rsqrt(jnp.mean(xf * xf, axis=-1, keepdims=True) + EPS)
    return (y * g.astype(jnp.float32)).astype(x.dtype)


def to_blocks(a):
    b, t = a.shape[:2]
    return jnp.moveaxis(a.reshape((b, t // Q_BLOCK, Q_BLOCK) + a.shape[2:]), 1, 0)


def from_blocks(a):
    a = jnp.moveaxis(a, 0, 1)
    return a.reshape((a.shape[0], a.shape[1] * a.shape[2]) + a.shape[3:])


def fox_block(q, k, v, cq, ck, qpos, kpos):
    s = jnp.einsum('bqhd,bkhd->bhqk', q.astype(jnp.float32), k.astype(jnp.float32)) * SCALE
    s = s + jnp.transpose(cq, (0, 2, 1))[..., :, None] - jnp.transpose(ck, (0, 2, 1))[..., None, :]
    mask = kpos[None, :] <= qpos[:, None]
    p = jax.nn.softmax(jnp.where(mask, s, -jnp.inf), axis=-1)
    return jnp.einsum('bhqk,bkhd->bqhd', p.astype(v.dtype), v)


def sb_block(q, k, v, qpos, kpos):
    z = jnp.einsum('bqhd,bkhd->bhqk', q.astype(jnp.float32), k.astype(jnp.float32)) * SCALE
    mask = kpos[None, :] < qpos[:, None]
    u = jnp.where(mask, jax.nn.log_sigmoid(-z), 0.0)
    rest = lax.cumsum(u, axis=3, reverse=True) - u
    a = jnp.where(mask, jnp.exp(jax.nn.log_sigmoid(z) + rest), 0.0)
    return jnp.einsum('bhqk,bkhd->bqhd', a.astype(v.dtype), v)


def mem_attend(qm, mk, mv):
    s = jnp.einsum('bqhd,bmhd->bhqm', qm.astype(jnp.float32), mk.astype(jnp.float32)) * SCALE
    p = jax.nn.softmax(s, axis=-1)
    return jnp.einsum('bhqm,bmhd->bqhd', p.astype(mv.dtype), mv)


def heads(a, n):
    b, t = a.shape[:2]
    return a.reshape(b, t, n, HEAD_DIM)


def fox_mixer(hn, w_in, b_f, past):
    proj = hn @ w_in
    q, k, v, fg, qm = jnp.split(proj, [MIX_WIDTH, 2 * MIX_WIDTH, 3 * MIX_WIDTH, 3 * MIX_WIDTH + N_HEADS], axis=-1)
    q, k, v = heads(q, N_HEADS), heads(k, N_HEADS), heads(v, N_HEADS)
    logf = jax.nn.log_sigmoid((fg + b_f).astype(jnp.float32))
    t = hn.shape[1]
    if past is None:
        c = jnp.cumsum(logf, axis=1)
        pos = jnp.arange(t)
        def body(a):
            qb, cb, pb = a
            return fox_block(qb, k, v, cb, c, pb, pos)
        o = from_blocks(lax.map(body, (to_blocks(q), to_blocks(c), pos.reshape(-1, Q_BLOCK))))
    else:
        pk, pv, plf = past
        p_len = pk.shape[1]
        k_all = jnp.concatenate([pk.astype(k.dtype), k], axis=1)
        v_all = jnp.concatenate([pv.astype(v.dtype), v], axis=1)
        c_all = jnp.cumsum(jnp.concatenate([plf.astype(jnp.float32), logf], axis=1), axis=1)
        o = fox_block(q, k_all, v_all, c_all[:, p_len:], c_all, p_len + jnp.arange(t), jnp.arange(p_len + t))
    return o, heads(qm, N_MEM_HEADS), (k, v, logf)


def sb_mixer(hn, w_in, past):
    proj = hn @ w_in
    q, k, v, qm = jnp.split(proj, [MIX_WIDTH, 2 * MIX_WIDTH, 3 * MIX_WIDTH], axis=-1)
    q, k, v = heads(q, N_HEADS), heads(k, N_HEADS), heads(v, N_HEADS)
    t = hn.shape[1]
    if past is None:
        pos = jnp.arange(t)
        def body(a):
            qb, pb = a
            return sb_block(qb, k, v, pb, pos)
        o = from_blocks(lax.map(body, (to_blocks(q), pos.reshape(-1, Q_BLOCK))))
    else:
        pk, pv = past
        p_len = pk.shape[1]
        k_all = jnp.concatenate([pk.astype(k.dtype), k], axis=1)
        v_all = jnp.concatenate([pv.astype(v.dtype), v], axis=1)
        o = sb_block(q, k_all, v_all, p_len + jnp.arange(t), jnp.arange(p_len + t))
    return o, heads(qm, N_MEM_HEADS), (k, v)


def finish_layer(x, o_mix, qm, mk, mv, w_out, g_ffn, w_gate_up, w_down):
    b, t = x.shape[:2]
    o_mem = mem_attend(qm, mk, mv)
    o = jnp.concatenate([o_mix.reshape(b, t, MIX_WIDTH), o_mem.reshape(b, t, MEM_WIDTH)], axis=-1)
    x = x + o @ w_out
    gate, up = jnp.split(rmsnorm(x, g_ffn) @ w_gate_up, 2, axis=-1)
    return x + (jax.nn.silu(gate) * up) @ w_down


def setup_inputs(seed: int = 0) -> dict:
    key = jax.random.key(seed)
    ks = jax.random.split(key, 24)
    nrm = lambda k, shape, s=1.0: jax.random.normal(k, shape, jnp.float32) * s
    return {
        "x_prompt": nrm(ks[0], (BATCH, SEQ, D_MODEL)),
        "x_sample": nrm(ks[1], (DEC_BATCH, DEC_SEQ, D_MODEL)),
        "mem_prompt": nrm(ks[2], (BATCH, N_MEM, D_MODEL)),
        "cache_fox_k": nrm(ks[3], (N_FOX, DEC_BATCH, PAST_LEN, N_HEADS, HEAD_DIM)),
        "cache_fox_v": nrm(ks[4], (N_FOX, DEC_BATCH, PAST_LEN, N_HEADS, HEAD_DIM)),
        "cache_fox_logf": jax.nn.log_sigmoid(2.0 + nrm(ks[5], (N_FOX, DEC_BATCH, PAST_LEN, N_HEADS))),
        "cache_sb_k": nrm(ks[6], (N_SB, DEC_BATCH, PAST_LEN, N_HEADS, HEAD_DIM)),
        "cache_sb_v": nrm(ks[7], (N_SB, DEC_BATCH, PAST_LEN, N_HEADS, HEAD_DIM)),
        "cache_mem_k": nrm(ks[8], (DEPTH, DEC_BATCH, N_MEM, N_MEM_HEADS, HEAD_DIM)),
        "cache_mem_v": nrm(ks[9], (DEPTH, DEC_BATCH, N_MEM, N_MEM_HEADS, HEAD_DIM)),
        "g_mix": 1.0 + nrm(ks[10], (DEPTH, D_MODEL), 0.02),
        "w_in_fox": nrm(ks[11], (N_FOX, D_MODEL, FOX_IN), D_MODEL ** -0.5),
        "b_f": 2.0 + nrm(ks[12], (N_FOX, N_HEADS), 0.5),
        "w_in_sb": nrm(ks[13], (N_SB, D_MODEL, SB_IN), D_MODEL ** -0.5),
        "g_mem": 1.0 + nrm(ks[14], (DEPTH, D_MODEL), 0.02),
        "w_mem_kv": nrm(ks[15], (DEPTH, D_MODEL, 2 * MEM_WIDTH), D_MODEL ** -0.5),
        "w_out": nrm(ks[16], (DEPTH, MIX_WIDTH + MEM_WIDTH, D_MODEL), (MIX_WIDTH + MEM_WIDTH) ** -0.5),
        "g_ffn": 1.0 + nrm(ks[17], (DEPTH, D_MODEL), 0.02),
        "w_gate_up": nrm(ks[18], (DEPTH, D_MODEL, 2 * D_FF), D_MODEL ** -0.5),
        "w_down": nrm(ks[19], (DEPTH, D_FF, D_MODEL), D_FF ** -0.5),
        "g_final": 1.0 + nrm(ks[20], (D_MODEL,), 0.02),
    }


def reference(x_prompt, x_sample, mem_prompt, cache_fox_k, cache_fox_v, cache_fox_logf, cache_sb_k, cache_sb_v,
              cache_mem_k, cache_mem_v, g_mix, w_in_fox, b_f, w_in_sb, g_mem, w_mem_kv, w_out, g_ffn,
              w_gate_up, w_down, g_final):
    xp, xs = x_prompt, x_sample
    fk_p, fv_p, fl_p, sk_p, sv_p, mk_p_l, mv_p_l = [], [], [], [], [], [], []
    fk_s, fv_s, fl_s, sk_s, sv_s = [], [], [], [], []
    for i in range(DEPTH):
        j = i // 2
        mkv = rmsnorm(mem_prompt, g_mem[i]) @ w_mem_kv[i]
        mk_p, mv_p = jnp.split(mkv, 2, axis=-1)
        mk_p, mv_p = heads(mk_p, N_MEM_HEADS), heads(mv_p, N_MEM_HEADS)
        mk_p_l.append(mk_p)
        mv_p_l.append(mv_p)
        hp = rmsnorm(xp, g_mix[i])
        hs = rmsnorm(xs, g_mix[i])
        if i % 2 == 0:
            op, qmp, (k, v, lf) = fox_mixer(hp, w_in_fox[j], b_f[j], None)
            os_, qms, (k2, v2, lf2) = fox_mixer(hs, w_in_fox[j], b_f[j],
                                                (cache_fox_k[j], cache_fox_v[j], cache_fox_logf[j]))
            fk_p.append(k); fv_p.append(v); fl_p.append(lf)
            fk_s.append(k2); fv_s.append(v2); fl_s.append(lf2)
        else:
            op, qmp, (k, v) = sb_mixer(hp, w_in_sb[j], None)
            os_, qms, (k2, v2) = sb_mixer(hs, w_in_sb[j], (cache_sb_k[j], cache_sb_v[j]))
            sk_p.append(k); sv_p.append(v)
            sk_s.append(k2); sv_s.append(v2)
        xp = finish_layer(xp, op, qmp, mk_p, mv_p, w_out[i], g_ffn[i], w_gate_up[i], w_down[i])
        xs = finish_layer(xs, os_, qms, cache_mem_k[i].astype(xs.dtype), cache_mem_v[i].astype(xs.dtype),
                          w_out[i], g_ffn[i], w_gate_up[i], w_down[i])
    y_prompt = rmsnorm(xp, g_final)
    y_sample = rmsnorm(xs, g_final)
    return (y_prompt, y_sample,
            jnp.stack(fk_p), jnp.stack(fv_p), jnp.stack(fl_p), jnp.stack(sk_p), jnp.stack(sv_p),
            jnp.stack(mk_p_l), jnp.stack(mv_p_l),
            jnp.stack(fk_s), jnp.stack(fv_s), jnp.stack(fl_s), jnp.stack(sk_s), jnp.stack(sv_s))
```

```cpp
#include <hip/hip_runtime.h>
#include <hip/hip_cooperative_groups.h>
#include <cstdio>
#include <cstdint>
namespace cg = cooperative_groups;

#ifndef ONE_LAUNCH
#define ONE_LAUNCH 1
#endif

#ifndef SP2V
#define SP2V true
#endif
#ifndef DUP
#define DUP 0
#endif
#ifndef NO_PIN
#define NO_PIN 0
#endif
#ifndef NO_ATT
#define NO_ATT 0
#endif
#ifndef NO_POUT
#define NO_POUT 0
#endif
#ifndef NO_PGU
#define NO_PGU 0
#endif
#ifndef NO_PDN
#define NO_PDN 0
#endif
#ifndef NO_P0
#define NO_P0 0
#endif
#define LAS __attribute__((address_space(3)))
typedef unsigned short bf16_t;
typedef short bf16x8 __attribute__((ext_vector_type(8)));
typedef short s16x4 __attribute__((ext_vector_type(4)));
typedef float f32x4 __attribute__((ext_vector_type(4)));
typedef float f32x16 __attribute__((ext_vector_type(16)));
typedef unsigned u32x4 __attribute__((ext_vector_type(4)));
typedef unsigned u32x2 __attribute__((ext_vector_type(2)));

constexpr int DM = 1024, SEQ = 2048, NB = 8, DSEQ = 64, PAST = 2048, NH = 12, HD = 64, NMH = 4, NMEM = 256, DFF = 2816;
constexpr int MP = NB * SEQ;
constexpr int MS = NB * DSEQ;
constexpr int MTOT = MP + MS;
constexpr int MIXW = 768;
constexpr int NIN_PAD = 2816;
constexpr float EPS = 1e-6f;
constexpr float LOG2E = 1.4426950408889634f;
constexpr float QSCALE = 0.125f * LOG2E;

constexpr size_t O_YP = 0;
constexpr size_t O_YS = O_YP + (size_t)MP * DM;
constexpr size_t O_FKP = O_YS + (size_t)MS * DM;
constexpr size_t KVP_L = (size_t)MP * MIXW;
constexpr size_t O_FVP = O_FKP + 2 * KVP_L;
constexpr size_t O_FLP = O_FVP + 2 * KVP_L;
constexpr size_t O_SKP = O_FLP + 2 * (size_t)MP * NH;
constexpr size_t O_SVP = O_SKP + 2 * KVP_L;
constexpr size_t O_MKP = O_SVP + 2 * KVP_L;
constexpr size_t MKV_L = (size_t)NB * NMEM * 256;
constexpr size_t O_MVP = O_MKP + 4 * MKV_L;
constexpr size_t O_FKS = O_MVP + 4 * MKV_L;
constexpr size_t KVS_L = (size_t)MS * MIXW;
constexpr size_t O_FVS = O_FKS + 2 * KVS_L;
constexpr size_t O_FLS = O_FVS + 2 * KVS_L;
constexpr size_t O_SKS = O_FLS + 2 * (size_t)MS * NH;
constexpr size_t O_SVS = O_SKS + 2 * KVS_L;
constexpr size_t O_END = O_SVS + 2 * KVS_L;

constexpr size_t al256(size_t x) { return (x + 255) & ~(size_t)255; }
constexpr size_t WS_CTR = 0;
constexpr size_t WS_KNMAX = 2048;
constexpr size_t WS_BAR = 4096;
constexpr size_t WS_WIN = 32768;
constexpr size_t WS_WOUT = WS_WIN + (size_t)4 * NIN_PAD * DM * 2;
constexpr size_t WS_WGU = WS_WOUT + (size_t)4 * DM * DM * 2;
constexpr size_t WS_WDN = WS_WGU + (size_t)4 * 2 * DFF * DM * 2;
constexpr size_t WS_WMKV = WS_WDN + (size_t)4 * DM * DFF * 2;
constexpr size_t WS_XB = WS_WMKV + (size_t)4 * 512 * DM * 2;
constexpr size_t WS_XF = WS_XB + (size_t)MTOT * DM * 2;
constexpr size_t WS_QHP = WS_XF + (size_t)MTOT * DM * 4;
constexpr size_t WS_QHS = WS_QHP + (size_t)NB * NH * SEQ * HD * 2;
constexpr size_t WS_QMP = WS_QHS + (size_t)NB * NH * DSEQ * HD * 2;
constexpr size_t WS_QMS = WS_QMP + (size_t)NB * NMH * SEQ * HD * 2;
constexpr size_t WS_KH = WS_QMS + (size_t)NB * NMH * DSEQ * HD * 2;
constexpr size_t WS_VT = WS_KH + (size_t)NB * NH * SEQ * HD * 2;
constexpr size_t WS_OB = WS_VT + (size_t)NB * NH * SEQ * HD * 2;
constexpr size_t WS_ACT = WS_OB + (size_t)MTOT * DM * 2;
constexpr size_t WS_MPB = WS_ACT + (size_t)MTOT * DFF * 2;
constexpr size_t WS_MKB = WS_MPB + (size_t)NB * NMEM * DM * 2;
constexpr size_t WS_MVT = WS_MKB + (size_t)4 * NB * NMH * NMEM * HD * 2;
constexpr size_t WS_SSQA = WS_MVT + (size_t)4 * NB * NMH * NMEM * HD * 2;
constexpr size_t WS_SSQB = WS_SSQA + (size_t)MTOT * 16 * 4;
constexpr size_t WS_RSTDM = WS_SSQB + (size_t)MTOT * 16 * 4;
constexpr size_t WS_END = al256(WS_RSTDM + (size_t)NB * NMEM * 4);
constexpr size_t WS_DXF = WS_END, WS_DXB = WS_DXF + (size_t)MTOT * DM * 4, WS_DSSQ = WS_DXB + (size_t)MTOT * DM * 2, WS_DEND = WS_DSSQ + (size_t)MTOT * 16 * 4;

typedef float f32x2_t __attribute__((ext_vector_type(2))); typedef __bf16 bf16x2_t __attribute__((ext_vector_type(2)));
__device__ __forceinline__ unsigned cvt_pk_bf16(float lo, float hi) { const f32x2_t v = {lo, hi}; const bf16x2_t b = __builtin_convertvector(v, bf16x2_t); return __builtin_bit_cast(unsigned, b); }
__device__ __forceinline__ u32x2 pack4(f32x4 v) { u32x2 w; w.x = cvt_pk_bf16(v[0], v[1]); w.y = cvt_pk_bf16(v[2], v[3]); return w; }
__device__ __forceinline__ u32x4 pack8(f32x4 a, f32x4 b) { u32x4 w; w.x = cvt_pk_bf16(a[0], a[1]); w.y = cvt_pk_bf16(a[2], a[3]); w.z = cvt_pk_bf16(b[0], b[1]); w.w = cvt_pk_bf16(b[2], b[3]); return w; }
__device__ __forceinline__ bf16_t f2bf(float f) { unsigned u = __builtin_bit_cast(unsigned, f); return (bf16_t)((u + 0x7fffu + ((u >> 16) & 1u)) >> 16); }

namespace pg8 {
#define PG8_LAS __attribute__((address_space(3)))
constexpr int BM = 256, BK = 64, HALF = 128, HTB = HALF * BK * 2, STAGE_BYTES = 8 * HTB, NXCD = 8, WGM = 8;
__host__ __device__ __forceinline__ int lds_byte(int r, int c) { const int st = (r >> 4) * 2 + (c >> 5), rr = r & 15, cc = c & 31, ob = rr * 64 + cc * 2; return st * 1024 + (ob ^ (((ob >> 9) & 1) << 5)); }
__host__ __device__ __forceinline__ void stage_rc(int b, int& R, int& C) { const int st = b / 1024, sb = b % 1024, swz = sb ^ (((sb >> 9) & 1) << 5); R = (st >> 1) * 16 + swz / 64; C = (st & 1) * 32 + (swz % 64) / 2; }
__host__ __device__ __forceinline__ int perm32(int rho) { const int n = rho >> 4, i = rho & 15; return 8 * (i >> 2) + 4 * n + (i & 3); }
struct Unit { int pm, pn; };
struct Gemm { const bf16_t* A; const bf16_t* Bt; int M, N, K; };
struct StaticOrder {
    int nM, nN, nwg, G, c;
    __host__ __device__ void init(int M, int N, int G_, int c_) { nM = M / BM; nN = N / BM; nwg = nM * nN; G = G_; c = c_; }
    __host__ __device__ bool next(int i, Unit& u) const {
        const long L = (long)i * G + c; if (L >= nwg) return false;
        int wgid = (int)L; { const int q = nwg / NXCD, r = nwg % NXCD, xcd = wgid % NXCD, off = wgid / NXCD; wgid = (xcd < r ? xcd * (q + 1) : r * (q + 1) + (xcd - r) * q) + off; }
        const int nig = WGM * nN, gid = wgid / nig, fm = gid * WGM, gsz = (nM - fm) < WGM ? (nM - fm) : WGM;
        u.pm = fm + ((wgid % nig) % gsz); u.pn = (wgid % nig) / gsz; return true;
    }
    __device__ __forceinline__ void a_ready(const Unit&) const {}
    __device__ __forceinline__ void done(const Unit&) const {}
};

template <class Epi, class Sched, bool ALIGN_EPI = false, bool SP2 = false>
__device__ __forceinline__ void gemm_phase(PG8_LAS unsigned char* lds, const Gemm g, const Sched& S, const Epi& E) {
    int tid_ = threadIdx.x; asm volatile("" : "+v"(tid_));
    const int tid = tid_, wid = __builtin_amdgcn_readfirstlane(tid >> 6), lane = tid & 63, wr = wid >> 2, wc = wid & 3, fr = lane & 15, fq = lane >> 4;
    const int K = g.K, nt = K / BK;
    unsigned voffA[2], voffB[2];
#pragma unroll
    for (int i = 0; i < 2; ++i) { int R, C; stage_rc(tid * 16 + i * 8192, R, C); const int Rb = Epi::PERM ? ((R & ~31) + perm32(R & 31)) : R;
        voffA[i] = (unsigned)(R * K + C) * 2u; voffB[i] = (unsigned)(Rb * K + C) * 2u; }
    const size_t kstep = (size_t)(BK * 2);
    const size_t hstep = (size_t)HALF * K * 2;
    const size_t tstep = 2 * hstep;
    const unsigned ldsw = (unsigned)wid * 1024u;
    const int aoff = lds_byte(wr * 64 + fr, fq * 8), boff = lds_byte(wc * 32 + fr, fq * 8);
#define PG8_SA(b, h) (((b) * 2 + (h)) * HTB)
#define PG8_SB(b, h) ((4 + (b) * 2 + (h)) * HTB)
#define PG8_STAGE(bufoff, gbase, voff) do { _Pragma("unroll") for (int _i = 0; _i < 2; ++_i) \
        __builtin_amdgcn_global_load_lds((const unsigned*)((const char*)(gbase) + (voff)[_i]), (PG8_LAS unsigned*)(lds + (bufoff) + ldsw + _i * 8192), 16, 0, 0); } while (0)
#define PG8_LDA(dst, b, h) do { _Pragma("unroll") for (int m = 0; m < 4; ++m) _Pragma("unroll") for (int k = 0; k < 2; ++k) dst[m][k] = *(const PG8_LAS bf16x8*)(lds + PG8_SA(b, h) + aoff + m * 2048 + k * 1024); } while (0)
#define PG8_LDB(dst, b, h) do { _Pragma("unroll") for (int n = 0; n < 2; ++n) _Pragma("unroll") for (int k = 0; k < 2; ++k) dst[n][k] = *(const PG8_LAS bf16x8*)(lds + PG8_SB(b, h) + boff + n * 2048 + k * 1024); } while (0)
#define PG8_MMA(ai, bj, At, Bt) do { __builtin_amdgcn_s_setprio(1); _Pragma("unroll") for (int m = 0; m < 4; ++m) _Pragma("unroll") for (int n = 0; n < 2; ++n) _Pragma("unroll") for (int k = 0; k < 2; ++k) \
        acc[ai][bj][m][n] = __builtin_amdgcn_mfma_f32_16x16x32_bf16(Bt[n][k], At[m][k], acc[ai][bj][m][n], 0, 0, 0); __builtin_amdgcn_s_setprio(0); } while (0)
#define PG8_WAIT_V(n) asm volatile("s_waitcnt vmcnt(" #n ")" ::: "memory")
#define PG8_WAIT_L(n) asm volatile("s_waitcnt lgkmcnt(" #n ")" ::: "memory")
#define PG8_BAR __builtin_amdgcn_s_barrier()
#define PG8_SCHED __builtin_amdgcn_sched_barrier(0)
    Unit cur, nxt; int ui = 0;
    if (!S.next(0, cur)) return;
    f32x4 acc[2][2][4][2];
#pragma unroll
    for (int a = 0; a < 2; ++a)
#pragma unroll
        for (int b = 0; b < 2; ++b)
#pragma unroll
            for (int m = 0; m < 4; ++m)
#pragma unroll
                for (int n = 0; n < 2; ++n) acc[a][b][m][n] = (f32x4){0.f, 0.f, 0.f, 0.f};
    bf16x8 At[4][2], B0[2][2], B1[2][2];
    const char* cA = (const char*)g.A + (size_t)cur.pm * tstep; const char* cB = (const char*)g.Bt + (size_t)cur.pn * tstep;
    S.a_ready(cur);
    if constexpr (SP2) {
        PG8_STAGE(PG8_SB(0, 0), cB, voffB); PG8_STAGE(PG8_SB(0, 1), cB + hstep, voffB); PG8_STAGE(PG8_SA(0, 0), cA, voffA); PG8_STAGE(PG8_SA(0, 1), cA + hstep, voffA);
        if (wr == 1) PG8_BAR;
        PG8_WAIT_V(2); PG8_BAR;
        PG8_STAGE(PG8_SB(1, 0), cB + kstep, voffB); PG8_STAGE(PG8_SA(1, 0), cA + kstep, voffA); PG8_STAGE(PG8_SB(1, 1), cB + hstep + kstep, voffB);
        PG8_WAIT_V(6); PG8_BAR;
    } else {
        PG8_STAGE(PG8_SB(0, 0), cB, voffB); PG8_STAGE(PG8_SA(0, 0), cA, voffA); PG8_STAGE(PG8_SB(0, 1), cB + hstep, voffB); PG8_STAGE(PG8_SA(0, 1), cA + hstep, voffA);
        if (wr == 1) PG8_BAR;
        PG8_WAIT_V(4); PG8_BAR;
        PG8_STAGE(PG8_SB(1, 0), cB + kstep, voffB); PG8_STAGE(PG8_SA(1, 0), cA + kstep, voffA); PG8_STAGE(PG8_SB(1, 1), cB + hstep + kstep, voffB);
        PG8_WAIT_V(6); PG8_BAR;
    }
    for (;;) {
        const bool has_next = S.next(ui + 1, nxt);
        const char* nA = has_next ? (const char*)g.A + (size_t)nxt.pm * tstep : cA; const char* nB = has_next ? (const char*)g.Bt + (size_t)nxt.pn * tstep : cB;
        for (int t = 0; t < nt; t += 2) {
            const bool last = (t == nt - 2);
            const char* a1 = cA + (size_t)(t + 1) * kstep;
            const char* a2 = last ? nA : cA + (size_t)(t + 2) * kstep; const char* b2 = last ? nB : cB + (size_t)(t + 2) * kstep;
            const char* a3 = a2 + kstep; const char* b3 = b2 + kstep;
            if (last && has_next) S.a_ready(nxt);
            if constexpr (SP2) {
            PG8_LDB(B0, 0, 0); PG8_LDB(B1, 0, 1); PG8_SCHED; PG8_LDA(At, 0, 0); PG8_STAGE(PG8_SA(1, 1), a1 + hstep, voffA);
            PG8_WAIT_V(8); PG8_WAIT_L(0); PG8_BAR; PG8_MMA(0, 0, At, B0); PG8_MMA(0, 1, At, B1); PG8_BAR; PG8_SCHED;
            PG8_LDA(At, 0, 1); PG8_STAGE(PG8_SB(0, 0), b2, voffB); PG8_STAGE(PG8_SB(0, 1), b2 + hstep, voffB); PG8_STAGE(PG8_SA(0, 0), a2, voffA);
            PG8_WAIT_V(8); PG8_WAIT_L(0); PG8_BAR; PG8_MMA(1, 0, At, B0); PG8_MMA(1, 1, At, B1); PG8_BAR; PG8_SCHED;
            PG8_LDB(B0, 1, 0); PG8_LDB(B1, 1, 1); PG8_SCHED; PG8_LDA(At, 1, 0); PG8_STAGE(PG8_SA(0, 1), a2 + hstep, voffA);
            PG8_WAIT_V(8); PG8_WAIT_L(0); PG8_BAR; PG8_MMA(0, 0, At, B0); PG8_MMA(0, 1, At, B1); PG8_BAR; PG8_SCHED;
            PG8_LDA(At, 1, 1); PG8_STAGE(PG8_SB(1, 0), b3, voffB); PG8_STAGE(PG8_SB(1, 1), b3 + hstep, voffB); PG8_STAGE(PG8_SA(1, 0), a3, voffA);
            PG8_WAIT_V(8); PG8_WAIT_L(0); PG8_BAR; PG8_MMA(1, 0, At, B0); PG8_MMA(1, 1, At, B1); PG8_BAR; PG8_SCHED;
            } else {
            PG8_LDB(B0, 0, 0); PG8_SCHED; PG8_LDA(At, 0, 0); PG8_STAGE(PG8_SA(1, 1), a1 + hstep, voffA);
            PG8_WAIT_L(8); PG8_BAR; PG8_WAIT_L(0); PG8_MMA(0, 0, At, B0); PG8_BAR; PG8_SCHED;
            PG8_LDB(B1, 0, 1); PG8_STAGE(PG8_SB(0, 0), b2, voffB);
            PG8_BAR; PG8_WAIT_L(0); PG8_MMA(0, 1, At, B1); PG8_BAR;
            PG8_LDA(At, 0, 1); PG8_STAGE(PG8_SA(0, 0), a2, voffA);
            PG8_BAR; PG8_WAIT_L(0); PG8_MMA(1, 0, At, B0); PG8_BAR; PG8_SCHED;
            PG8_STAGE(PG8_SB(0, 1), b2 + hstep, voffB);
            PG8_WAIT_V(6); PG8_BAR; PG8_MMA(1, 1, At, B1); PG8_BAR;
            PG8_LDB(B0, 1, 0); PG8_SCHED; PG8_LDA(At, 1, 0); PG8_STAGE(PG8_SA(0, 1), a2 + hstep, voffA);
            PG8_WAIT_L(8); PG8_BAR; PG8_WAIT_L(0); PG8_MMA(0, 0, At, B0); PG8_BAR; PG8_SCHED;
            PG8_LDB(B1, 1, 1); PG8_STAGE(PG8_SB(1, 0), b3, voffB);
            PG8_BAR; PG8_WAIT_L(0); PG8_MMA(0, 1, At, B1); PG8_BAR;
            PG8_LDA(At, 1, 1); PG8_STAGE(PG8_SA(1, 0), a3, voffA);
            PG8_BAR; PG8_WAIT_L(0); PG8_MMA(1, 0, At, B0); PG8_BAR; PG8_SCHED;
            PG8_STAGE(PG8_SB(1, 1), b3 + hstep, voffB);
            PG8_WAIT_V(6); PG8_BAR; PG8_MMA(1, 1, At, B1); PG8_BAR;
            }
        }
        if constexpr (ALIGN_EPI) { if (wr == 0) PG8_BAR; }
        if constexpr (!Epi::AFTER_DRAIN) { E(acc, cur, wr, wc, fr, fq); S.done(cur); }
        if (!has_next) break;
#pragma unroll
        for (int a = 0; a < 2; ++a)
#pragma unroll
            for (int b = 0; b < 2; ++b)
#pragma unroll
                for (int m = 0; m < 4; ++m)
#pragma unroll
                    for (int n = 0; n < 2; ++n) acc[a][b][m][n] = (f32x4){0.f, 0.f, 0.f, 0.f};
        cur = nxt; cA = nA; cB = nB; ++ui;
        if constexpr (ALIGN_EPI) { if (wr == 1) PG8_BAR; }
    }
    PG8_WAIT_V(0);
    if constexpr (!ALIGN_EPI) { if (wr == 0) PG8_BAR; }
    PG8_BAR;
#undef PG8_SA
#undef PG8_SB
#undef PG8_STAGE
#undef PG8_LDA
#undef PG8_LDB
#undef PG8_MMA
#undef PG8_WAIT_V
#undef PG8_WAIT_L
#undef PG8_BAR
#undef PG8_SCHED
}
}

__device__ __forceinline__ float rstd16(const float* ssq, int row) {
    const f32x4* p = (const f32x4*)(ssq + (size_t)row * 16); const f32x4 a = p[0], b = p[1], c = p[2], d = p[3];
    const float s = ((a[0] + a[1]) + (a[2] + a[3])) + ((b[0] + b[1]) + (b[2] + b[3])) + ((c[0] + c[1]) + (c[2] + c[3])) + ((d[0] + d[1]) + (d[2] + d[3]));
    return rsqrtf(s * (1.0f / DM) + EPS);
}

__device__ __forceinline__ float rstd16c(const float* ssq, int row, int fq) {
    const f32x4 a = *(const f32x4*)(ssq + (size_t)row * 16 + fq * 4);
    float s = (a[0] + a[1]) + (a[2] + a[3]); s += __shfl_xor(s, 16); s += __shfl_xor(s, 32);
    return rsqrtf(s * (1.0f / DM) + EPS);
}

struct EpiIn {
    static constexpr bool PERM = true, AFTER_DRAIN = false;
    unsigned char* ws; float* out; const float* bf; int fox, j;
    __device__ __forceinline__ void operator()(const f32x4 (&acc)[2][2][4][2], const pg8::Unit& u, int wr, int wc, int fr_, int fq_) const {
        int fr = fr_, fq = fq_; asm volatile("" : "+v"(fr), "+v"(fq));
        const int pn = u.pn; const bool samp = (u.pm >= MP / 256);
        const float* ssq = (const float*)(ws + WS_SSQA);
        float kmx[2] = {0.f, 0.f};
        float rsv[2][4];
#pragma unroll
        for (int ai = 0; ai < 2; ++ai)
#pragma unroll
            for (int m = 0; m < 4; ++m) rsv[ai][m] = rstd16c(ssq, u.pm * 256 + ai * 128 + wr * 64 + m * 16 + fr, fq);
        asm volatile("" ::: "memory");
#pragma unroll
        for (int ai = 0; ai < 2; ++ai)
#pragma unroll
            for (int m = 0; m < 4; ++m) {
                const int row = u.pm * 256 + ai * 128 + wr * 64 + m * 16 + fr;
                const float rs = rsv[ai][m];
                int b, t, rl; if (!samp) { b = row >> 11; t = row & 2047; rl = row; } else { rl = row - MP; b = rl >> 6; t = rl & 63; }
                float kn2[2] = {0.f, 0.f};
#pragma unroll
                for (int bj = 0; bj < 2; ++bj) {
                    const int c = bj * 128 + wc * 32 + fq * 8;
                    f32x4 v0 = acc[ai][bj][m][0] * rs, v1 = acc[ai][bj][m][1] * rs;
                    if (pn < 3) {
                        const int cg_ = pn * 256 + c, h = cg_ >> 6, d = cg_ & 63; v0 = v0 * QSCALE; v1 = v1 * QSCALE;
                        bf16_t* dst = samp ? (bf16_t*)(ws + WS_QHS) + ((size_t)(b * NH + h) * DSEQ + t) * HD + d : (bf16_t*)(ws + WS_QHP) + ((size_t)(b * NH + h) * SEQ + t) * HD + d;
                        *(u32x4*)dst = pack8(v0, v1);
                    } else if (pn == 9) {
                        const int mh = c >> 6, d = c & 63; v0 = v0 * QSCALE; v1 = v1 * QSCALE;
                        bf16_t* dst = samp ? (bf16_t*)(ws + WS_QMS) + ((size_t)(b * NMH + mh) * DSEQ + t) * HD + d : (bf16_t*)(ws + WS_QMP) + ((size_t)(b * NMH + mh) * SEQ + t) * HD + d;
                        *(u32x4*)dst = pack8(v0, v1);
                    } else if (pn < 9) {
                        const bool isv = pn >= 6;
                        const int cg_ = (pn - (isv ? 6 : 3)) * 256 + c, h = cg_ >> 6, d = cg_ & 63;
                        const size_t obase = samp ? (fox ? (isv ? O_FVS : O_FKS) : (isv ? O_SVS : O_SKS)) + (size_t)j * KVS_L : (fox ? (isv ? O_FVP : O_FKP) : (isv ? O_SVP : O_SKP)) + (size_t)j * KVP_L;
                        float* op = out + obase + (size_t)rl * MIXW + cg_;
                        *(f32x4*)op = v0; *(f32x4*)(op + 4) = v1;
                        if (!isv) kn2[bj] += ((v0[0] * v0[0] + v0[1] * v0[1]) + (v0[2] * v0[2] + v0[3] * v0[3])) + ((v1[0] * v1[0] + v1[1] * v1[1]) + (v1[2] * v1[2] + v1[3] * v1[3]));
                        if (!samp) *(u32x4*)((bf16_t*)(ws + (isv ? WS_VT : WS_KH)) + ((size_t)(b * NH + h) * SEQ + t) * HD + d) = pack8(v0, v1);
                    } else {
                        if (bj == 0 && wc == 0 && fq < 2) {
                            float* olf = out + (samp ? O_FLS + (size_t)j * MS * NH : O_FLP + (size_t)j * MP * NH);
#pragma unroll
                            for (int n = 0; n < 2; ++n) if (fq == 0 || n == 0) {
#pragma unroll
                                for (int jj = 0; jj < 4; ++jj) { const int hh = fq * 8 + n * 4 + jj; const float x = (n == 0 ? v0[jj] : v1[jj]) + bf[hh];
                                    const float lf = fminf(x, 0.f) - log1pf(expf(-fabsf(x)));
                                    olf[(size_t)rl * NH + hh] = lf; }
                            }
                        }
                    }
                }
                if (fox && !samp && pn >= 3 && pn < 6) {
#pragma unroll
                    for (int bj = 0; bj < 2; ++bj) { float q2 = kn2[bj]; q2 += __shfl_xor(q2, 16); q2 += __shfl_xor(q2, 32); kmx[bj] = fmaxf(kmx[bj], q2); }
                }
            }
        if (fox && !samp && pn >= 3 && pn < 6) {
            const int b = (u.pm * 256) >> 11;
#pragma unroll
            for (int bj = 0; bj < 2; ++bj) { float mx = kmx[bj]; mx = fmaxf(mx, __shfl_xor(mx, 1)); mx = fmaxf(mx, __shfl_xor(mx, 2)); mx = fmaxf(mx, __shfl_xor(mx, 4)); mx = fmaxf(mx, __shfl_xor(mx, 8));
                const int head = (pn - 3) * 4 + bj * 2 + (wc >> 1);
                if (fr == 0 && fq == 0) atomicMax((unsigned*)(ws + WS_KNMAX) + ((size_t)(j * NB + b) * NH + head) * 2 + (wc & 1), __float_as_uint(mx)); }
        }
    }
};

struct EpiMKV {
    static constexpr bool PERM = true, AFTER_DRAIN = false;
    unsigned char* ws; float* out; int layer0;
    __device__ __forceinline__ void operator()(const f32x4 (&acc)[2][2][4][2], const pg8::Unit& u, int wr, int wc, int fr_, int fq_) const {
        int fr = fr_, fq = fq_; asm volatile("" : "+v"(fr), "+v"(fq));
        const int layer = layer0 + (u.pn >> 1); const bool isv = (u.pn & 1);
        const float* rstdm = (const float*)(ws + WS_RSTDM);
        float rsv[2][4];
#pragma unroll
        for (int ai = 0; ai < 2; ++ai)
#pragma unroll
            for (int m = 0; m < 4; ++m) rsv[ai][m] = rstdm[u.pm * 256 + ai * 128 + wr * 64 + m * 16 + fr];
        asm volatile("" ::: "memory");
#pragma unroll
        for (int ai = 0; ai < 2; ++ai)
#pragma unroll
            for (int m = 0; m < 4; ++m) {
                const int row = u.pm * 256 + ai * 128 + wr * 64 + m * 16 + fr; const int b = row >> 8, mm = row & 255;
                const float rs = rsv[ai][m];
#pragma unroll
                for (int bj = 0; bj < 2; ++bj) {
                    const int c = bj * 128 + wc * 32 + fq * 8; const int mh = c >> 6, d = c & 63;
                    const f32x4 v0 = acc[ai][bj][m][0] * rs, v1 = acc[ai][bj][m][1] * rs;
                    float* op = out + (isv ? O_MVP : O_MKP) + ((size_t)layer * (NB * NMEM) + row) * 256 + c;
                    *(f32x4*)op = v0; *(f32x4*)(op + 4) = v1;
                    *(u32x4*)((bf16_t*)(ws + (isv ? WS_MVT : WS_MKB)) + ((size_t)((layer * NB + b) * NMH + mh) * NMEM + mm) * HD + d) = pack8(v0, v1);
                }
            }
    }
};

__device__ __forceinline__ f32x4 unpack4(u32x2 w) { return (f32x4){__uint_as_float(w.x << 16), __uint_as_float(w.x & 0xffff0000u), __uint_as_float(w.y << 16), __uint_as_float(w.y & 0xffff0000u)}; }
struct EpiRes {
    static constexpr bool PERM = true, AFTER_DRAIN = false;
    unsigned char* ws; size_t ssq_off, xb_off;
    __device__ __forceinline__ void operator()(f32x4 (&acc)[2][2][4][2], const pg8::Unit& u, int wr, int wc, int fr_, int fq_) const {
        int fr = fr_, fq = fq_; asm volatile("" : "+v"(fr), "+v"(fq));
        const bf16_t* src = (const bf16_t*)(ws + WS_XB); bf16_t* xb = (bf16_t*)(ws + xb_off); float* ssq_out = (float*)(ws + ssq_off);
        const unsigned off0 = (unsigned)((u.pm * 256 + wr * 64 + fr) * DM + u.pn * 256 + wc * 32 + fq * 8);
        u32x4 r[2][4][2];
#pragma unroll
        for (int ai = 0; ai < 2; ++ai)
#pragma unroll
            for (int m = 0; m < 4; ++m)
#pragma unroll
                for (int bj = 0; bj < 2; ++bj) r[ai][m][bj] = *(const u32x4*)(src + off0 + (unsigned)((ai * 128 + m * 16) * DM + bj * 128));
#pragma unroll
        for (int ai = 0; ai < 2; ++ai)
#pragma unroll
            for (int m = 0; m < 4; ++m)
#pragma unroll
                for (int bj = 0; bj < 2; ++bj) { const u32x4 w = r[ai][m][bj]; acc[ai][bj][m][0] += unpack4((u32x2){w.x, w.y}); acc[ai][bj][m][1] += unpack4((u32x2){w.z, w.w}); }
        asm volatile("" ::: "memory");
#pragma unroll
        for (int ai = 0; ai < 2; ++ai)
#pragma unroll
            for (int m = 0; m < 4; ++m) {
                const int row = u.pm * 256 + ai * 128 + wr * 64 + m * 16 + fr;
                float ss = 0.f;
#pragma unroll
                for (int bj = 0; bj < 2; ++bj) {
                    const f32x4 v0 = acc[ai][bj][m][0], v1 = acc[ai][bj][m][1];
                    *(u32x4*)(xb + off0 + (unsigned)((ai * 128 + m * 16) * DM + bj * 128)) = pack8(v0, v1);
                    ss += ((v0[0] * v0[0] + v0[1] * v0[1]) + (v0[2] * v0[2] + v0[3] * v0[3])) + ((v1[0] * v1[0] + v1[1] * v1[1]) + (v1[2] * v1[2] + v1[3] * v1[3]));
                }
                ss += __shfl_xor(ss, 16); ss += __shfl_xor(ss, 32);
                if (fq == 0) ssq_out[(size_t)row * 16 + u.pn * 4 + wc] = ss;
            }
    }
};

struct EpiGU {
    static constexpr bool PERM = true, AFTER_DRAIN = false;
    unsigned char* ws;
    __device__ __forceinline__ void operator()(const f32x4 (&acc)[2][2][4][2], const pg8::Unit& u, int wr, int wc, int fr_, int fq_) const {
        int fr = fr_, fq = fq_; asm volatile("" : "+v"(fr), "+v"(fq));
        const float* ssq = (const float*)(ws + WS_SSQB); bf16_t* act = (bf16_t*)(ws + WS_ACT);
        float rsv[2][4];
#pragma unroll
        for (int ai = 0; ai < 2; ++ai)
#pragma unroll
            for (int m = 0; m < 4; ++m) rsv[ai][m] = rstd16c(ssq, u.pm * 256 + ai * 128 + wr * 64 + m * 16 + fr, fq);
        asm volatile("" ::: "memory");
#pragma unroll
        for (int ai = 0; ai < 2; ++ai)
#pragma unroll
            for (int m = 0; m < 4; ++m) {
                const int row = u.pm * 256 + ai * 128 + wr * 64 + m * 16 + fr;
                const float rs = rsv[ai][m];
                f32x4 a2[2];
#pragma unroll
                for (int n = 0; n < 2; ++n) {
                    const f32x4 g = acc[ai][0][m][n] * rs, up = acc[ai][1][m][n] * rs;
#pragma unroll
                    for (int j = 0; j < 4; ++j) a2[n][j] = g[j] * __builtin_amdgcn_rcpf(1.f + __expf(-g[j])) * up[j];
                }
                *(u32x4*)(act + (size_t)row * DFF + u.pn * 128 + wc * 32 + fq * 8) = pack8(a2[0], a2[1]);
            }
    }
};

__device__ __forceinline__ float wave_sum(float v) {
#pragma unroll
    for (int o = 1; o < 64; o <<= 1) v += __shfl_xor(v, o);
    return v;
}
__device__ __forceinline__ void tr_item(const float* src, int ldw, const float* g, bf16_t* dst, int ldk, int nvalid, LAS float* scr, int lane) {
    const int nn = lane & 31;
    float tv[32];
#pragma unroll
    for (int i = 0; i < 32; ++i) { const int kk = 2 * i + (lane >> 5); tv[i] = (nn < nvalid) ? src[(size_t)kk * ldw + nn] : 0.f; }
#pragma unroll
    for (int i = 0; i < 32; ++i) { const int kk = 2 * i + (lane >> 5); float v = tv[i]; if (g) v *= g[kk]; scr[kk * 33 + nn] = v; }
    asm volatile("s_waitcnt lgkmcnt(0)" ::: "memory");
    const int c = lane & 7;
#pragma unroll
    for (int j = 0; j < 4; ++j) { const int n = (lane >> 3) + 8 * j; const LAS float* s = scr + (8 * c) * 33 + n;
        u32x4 o; o.x = cvt_pk_bf16(s[0 * 33], s[1 * 33]); o.y = cvt_pk_bf16(s[2 * 33], s[3 * 33]); o.z = cvt_pk_bf16(s[4 * 33], s[5 * 33]); o.w = cvt_pk_bf16(s[6 * 33], s[7 * 33]);
        *(u32x4*)(dst + (size_t)n * ldk + 8 * c) = o; }
    asm volatile("s_waitcnt lgkmcnt(0)" ::: "memory");
}

__device__ __forceinline__ void small_res_gemm(LAS unsigned char* lds, const bf16_t* A, const bf16_t* Bt, int K, bf16_t* xb, float* ssq, int tile) {
    int tid_ = threadIdx.x; asm volatile("" : "+v"(tid_));
    const int tid = tid_, lane = tid & 63, wid = tid >> 6, fr = lane & 15, fq = lane >> 4;
    const int rt = tile >> 3, ct = tile & 7, row0 = rt * 16, colb = ct * 128;
    const int ksl = K >> 3, nsteps = ksl >> 5;
    const bf16_t* ap = A + (size_t)(row0 + fr) * K + wid * ksl + fq * 8; const bf16_t* bp = Bt + (size_t)(colb + fr) * K + wid * ksl + fq * 8;
    f32x4 acc[8];
#pragma unroll
    for (int n = 0; n < 8; ++n) acc[n] = (f32x4){0.f, 0.f, 0.f, 0.f};
    for (int s0 = 0; s0 < nsteps; s0 += 4) {
        bf16x8 a[4], b[4][8];
#pragma unroll
        for (int i = 0; i < 4; ++i) if (s0 + i < nsteps) { a[i] = *(const bf16x8*)(ap + (s0 + i) * 32);
#pragma unroll
            for (int n = 0; n < 8; ++n) b[i][n] = *(const bf16x8*)(bp + (size_t)n * 16 * K + (s0 + i) * 32); }
#pragma unroll
        for (int i = 0; i < 4; ++i) if (s0 + i < nsteps) {
#pragma unroll
            for (int n = 0; n < 8; ++n) acc[n] = __builtin_amdgcn_mfma_f32_16x16x32_bf16(a[i], b[i][n], acc[n], 0, 0, 0); }
    }
    LAS f32x4* part = (LAS f32x4*)lds;
    LAS float* red = (LAS float*)(lds + 65536);
#pragma unroll
    for (int n = 0; n < 8; ++n) part[(wid * 8 + n) * 64 + lane] = acc[n];
    __syncthreads();
    f32x4 tot = part[wid * 64 + lane];
#pragma unroll
    for (int w = 1; w < 8; ++w) tot += part[(w * 8 + wid) * 64 + lane];
    const int col0 = colb + wid * 16;
    float ssp[4];
#pragma unroll
    for (int j = 0; j < 4; ++j) { const size_t o = (size_t)(row0 + fq * 4 + j) * DM + col0 + fr; const float v = __uint_as_float((unsigned)xb[o] << 16) + tot[j]; xb[o] = f2bf(v); ssp[j] = v * v; }
#pragma unroll
    for (int j = 0; j < 4; ++j) { ssp[j] += __shfl_xor(ssp[j], 1); ssp[j] += __shfl_xor(ssp[j], 2); ssp[j] += __shfl_xor(ssp[j], 4); ssp[j] += __shfl_xor(ssp[j], 8); }
    if (fr == 0) {
#pragma unroll
        for (int j = 0; j < 4; ++j) red[wid * 16 + fq * 4 + j] = ssp[j];
    }
    __syncthreads();
    if (tid < 16) { float t = 0.f;
#pragma unroll
        for (int w = 0; w < 8; ++w) t += red[w * 16 + tid];
        ssq[(size_t)(row0 + tid) * 16 + ct] = t;
        if (ct == 0) { *(f32x4*)(ssq + (size_t)(row0 + tid) * 16 + 8) = (f32x4){0.f, 0.f, 0.f, 0.f}; *(f32x4*)(ssq + (size_t)(row0 + tid) * 16 + 12) = (f32x4){0.f, 0.f, 0.f, 0.f}; } }
    __syncthreads();
}

constexpr int KPITCH = 144, VPITCH = 192;
constexpr int A_KS = 0, A_VS = 2 * 64 * KPITCH, A_C2 = A_VS + 2 * 64 * VPITCH, A_SCAN = A_C2 + 2560 * 4, A_UNIT = A_SCAN + 64, A_FLAG = A_UNIT + 64, A_END = A_FLAG + 64;
constexpr float THR_SB = 32.f, THR_FOX = 40.f;
__device__ __forceinline__ int crow(int i, int h) { return (i & 3) + 8 * (i >> 2) + 4 * h; }

__device__ __forceinline__ void fox_cumsum(LAS float* c2, LAS float* scan, const float* A, int split, const float* B, int n) {
    int tid_ = threadIdx.x; asm volatile("" : "+v"(tid_));
    const int tid = tid_, lane = tid & 63, wid = tid >> 6;
    float v[5]; float s = 0.f; const int t0 = tid * 5;
#pragma unroll
    for (int e = 0; e < 5; ++e) { const int t = t0 + e; float x = 0.f; if (t < n) x = (t < split) ? A[(size_t)t * NH] : B[(size_t)(t - split) * NH]; s += x; v[e] = s; }
    float w = s;
#pragma unroll
    for (int off = 1; off < 64; off <<= 1) { const float y = __shfl_up(w, off); if (lane >= off) w += y; }
    if (lane == 63) scan[wid] = w;
    __syncthreads();
    float base = w - s;
    for (int k = 0; k < wid; ++k) base += scan[k];
#pragma unroll
    for (int e = 0; e < 5; ++e) { const int t = t0 + e; if (t < n) c2[t] = (base + v[e]) * LOG2E; }
    __syncthreads();
}

typedef short v4i16_t __attribute__((ext_vector_type(4)));
__device__ __forceinline__ s16x4 vtr(const LAS unsigned char* p) { return __builtin_bit_cast(s16x4, __builtin_amdgcn_ds_read_tr16_b64_v4i16((LAS v4i16_t*)p)); }
template <bool SB>
__device__ __forceinline__ void att_tile(const LAS unsigned char* ks, const LAS unsigned char* vs, int kt, const LAS float* c2, int h, int r, const bf16x8 (&qf)[4], bool needmask, int qpos,
                                         float& mrun, float& lrun, float& Rc, f32x16& o0, f32x16& o1) {
            const int kv0 = 64 * kt;
            f32x16 p0, p1;
            if (!SB && c2) {
#pragma unroll
                for (int g = 0; g < 4; ++g) { const f32x4 ca = *(const LAS f32x4*)(c2 + kv0 + 8 * g + 4 * h), cb = *(const LAS f32x4*)(c2 + kv0 + 32 + 8 * g + 4 * h);
#pragma unroll
                    for (int e = 0; e < 4; ++e) { p0[4 * g + e] = -ca[e]; p1[4 * g + e] = -cb[e]; } }
            } else {
#pragma unroll
                for (int i = 0; i < 16; ++i) { p0[i] = 0.f; p1[i] = 0.f; }
            }
#pragma unroll
            for (int s = 0; s < 4; ++s) {
                const bf16x8 a0 = *(const LAS bf16x8*)(ks + r * KPITCH + 32 * s + 16 * h);
                const bf16x8 a1 = *(const LAS bf16x8*)(ks + (32 + r) * KPITCH + 32 * s + 16 * h);
                p0 = __builtin_amdgcn_mfma_f32_32x32x16_bf16(a0, qf[s], p0, 0, 0, 0);
                p1 = __builtin_amdgcn_mfma_f32_32x32x16_bf16(a1, qf[s], p1, 0, 0, 0);
            }
            const LAS unsigned char* vtb = vs + (4 * h + ((r & 15) >> 2)) * VPITCH + (r >> 4) * 32 + (r & 3) * 8;
            s16x4 vlo0[4], vhi0[4], vlo1[4], vhi1[4];
#pragma unroll
            for (int ps = 0; ps < 4; ++ps) {
                vlo0[ps] = vtr(vtb + (16 * ps) * VPITCH); vhi0[ps] = vtr(vtb + (16 * ps + 8) * VPITCH);
                vlo1[ps] = vtr(vtb + (16 * ps) * VPITCH + 64); vhi1[ps] = vtr(vtb + (16 * ps + 8) * VPITCH + 64);
            }
            __builtin_amdgcn_sched_barrier(0);
            if constexpr (!SB) {
                if (needmask) {
#pragma unroll
                    for (int i = 0; i < 16; ++i) { const int kv = kv0 + crow(i, h); if (kv > qpos) p0[i] = -1e30f; if (kv + 32 > qpos) p1[i] = -1e30f; }
                }
                float tm = fmaxf(p0[0], p1[0]);
#pragma unroll
                for (int i = 1; i < 16; ++i) tm = fmaxf(tm, fmaxf(p0[i], p1[i]));
                tm = fmaxf(tm, __shfl_xor(tm, 32));
                const float mnew = fmaxf(mrun, tm);
                {
                    const float alpha = __builtin_amdgcn_exp2f(mrun - mnew); mrun = mnew; lrun *= alpha;
#pragma unroll
                    for (int i = 0; i < 16; ++i) { o0[i] *= alpha; o1[i] *= alpha; }
                }
                float rsum = 0.f;
#pragma unroll
                for (int i = 0; i < 16; ++i) { p0[i] = __builtin_amdgcn_exp2f(p0[i] - mrun); p1[i] = __builtin_amdgcn_exp2f(p1[i] - mrun); rsum += p0[i] + p1[i]; }
                lrun += rsum;
            } else {
                f32x16 B0, B1;
#pragma unroll
                for (int i = 0; i < 16; ++i) {
                    const float e0 = __builtin_amdgcn_exp2f(fminf(p0[i], 80.f)), e1 = __builtin_amdgcn_exp2f(fminf(p1[i], 80.f));
                    float m0 = __builtin_amdgcn_rcpf(1.f + e0), m1 = __builtin_amdgcn_rcpf(1.f + e1);
                    float b0 = e0 * m0, b1 = e1 * m1;
                    if (needmask) { const int kv = kv0 + crow(i, h); if (kv >= qpos) { m0 = 1.f; b0 = 0.f; } if (kv + 32 >= qpos) { m1 = 1.f; b1 = 0.f; } }
                    p0[i] = m0; p1[i] = m1; B0[i] = b0; B1[i] = b1;
                }
                float T[8], To[8];
#pragma unroll
                for (int g = 0; g < 4; ++g) { T[g] = (p0[4 * g] * p0[4 * g + 1]) * (p0[4 * g + 2] * p0[4 * g + 3]); T[4 + g] = (p1[4 * g] * p1[4 * g + 1]) * (p1[4 * g + 2] * p1[4 * g + 3]); }
#pragma unroll
                for (int k = 0; k < 8; ++k) To[k] = __shfl_xor(T[k], 32);
                float rc = Rc;
#pragma unroll
                for (int k = 7; k >= 0; --k) {
                    const float w3 = rc * (h == 0 ? To[k] : 1.f);
                    const int g = k & 3;
                    if (k >= 4) { const float w2 = w3 * p1[4 * g + 3], w1 = w2 * p1[4 * g + 2], w0 = w1 * p1[4 * g + 1];
                        p1[4 * g + 3] = B1[4 * g + 3] * w3; p1[4 * g + 2] = B1[4 * g + 2] * w2; p1[4 * g + 1] = B1[4 * g + 1] * w1; p1[4 * g] = B1[4 * g] * w0; }
                    else { const float w2 = w3 * p0[4 * g + 3], w1 = w2 * p0[4 * g + 2], w0 = w1 * p0[4 * g + 1];
                        p0[4 * g + 3] = B0[4 * g + 3] * w3; p0[4 * g + 2] = B0[4 * g + 2] * w2; p0[4 * g + 1] = B0[4 * g + 1] * w1; p0[4 * g] = B0[4 * g] * w0; }
                    rc *= T[k] * To[k];
                }
                Rc = rc;
            }
            bf16x8 pf[4];
            { u32x4 w;
              w.x = cvt_pk_bf16(p0[0], p0[1]); w.y = cvt_pk_bf16(p0[2], p0[3]); w.z = cvt_pk_bf16(p0[4], p0[5]); w.w = cvt_pk_bf16(p0[6], p0[7]); pf[0] = __builtin_bit_cast(bf16x8, w);
              w.x = cvt_pk_bf16(p0[8], p0[9]); w.y = cvt_pk_bf16(p0[10], p0[11]); w.z = cvt_pk_bf16(p0[12], p0[13]); w.w = cvt_pk_bf16(p0[14], p0[15]); pf[1] = __builtin_bit_cast(bf16x8, w);
              w.x = cvt_pk_bf16(p1[0], p1[1]); w.y = cvt_pk_bf16(p1[2], p1[3]); w.z = cvt_pk_bf16(p1[4], p1[5]); w.w = cvt_pk_bf16(p1[6], p1[7]); pf[2] = __builtin_bit_cast(bf16x8, w);
              w.x = cvt_pk_bf16(p1[8], p1[9]); w.y = cvt_pk_bf16(p1[10], p1[11]); w.z = cvt_pk_bf16(p1[12], p1[13]); w.w = cvt_pk_bf16(p1[14], p1[15]); pf[3] = __builtin_bit_cast(bf16x8, w); }
#pragma unroll
            for (int ps = 0; ps < 4; ++ps) {
                const s16x4 lo0 = vlo0[ps], hi0 = vhi0[ps], lo1 = vlo1[ps], hi1 = vhi1[ps];
                const bf16x8 va0 = (bf16x8){lo0[0], lo0[1], lo0[2], lo0[3], hi0[0], hi0[1], hi0[2], hi0[3]};
                const bf16x8 va1 = (bf16x8){lo1[0], lo1[1], lo1[2], lo1[3], hi1[0], hi1[1], hi1[2], hi1[3]};
                o0 = __builtin_amdgcn_mfma_f32_32x32x16_bf16(va0, pf[ps], o0, 0, 0, 0);
                o1 = __builtin_amdgcn_mfma_f32_32x32x16_bf16(va1, pf[ps], o1, 0, 0, 0);
            }
}

template <bool SB, bool F32>
__device__ __forceinline__ void attn_unit(LAS unsigned char* lds, const bf16_t* Q, int nq, int qpos0, const void* K1, const void* V1, int ld1,
                                          const float* K2, const float* V2, int ksplit, int ntile, bool causal, const LAS float* c2, bf16_t* O, float kmax,
                                          const float* csA = nullptr, int cs_split = 0, const float* csB = nullptr, int cs_n = 0) {
    int tid_ = threadIdx.x; asm volatile("" : "+v"(tid_));
    const int tid = tid_, lane = tid & 63, wid = __builtin_amdgcn_readfirstlane(tid >> 6), r = lane & 31, h = lane >> 5;
    const bool active = (wid * 32 < nq);
    bf16x8 qf[4];
#pragma unroll
    for (int s = 0; s < 4; ++s) qf[s] = active ? *(const bf16x8*)(Q + (size_t)(wid * 32 + r) * HD + 16 * s + 8 * h) : (bf16x8){0, 0, 0, 0, 0, 0, 0, 0};
    const int qmin = qpos0 + wid * 32, qmax = qmin + 31, qpos = qmin + r;
    const bool prune = SB || (kmax > 0.f);
    float qn = 0.f;
    if (!SB && prune) {
#pragma unroll
        for (int s_ = 0; s_ < 4; ++s_)
#pragma unroll
            for (int e = 0; e < 8; ++e) { const float f = __uint_as_float(((unsigned)(unsigned short)qf[s_][e]) << 16); qn += f * f; }
        qn += __shfl_xor(qn, 32); qn = sqrtf(qn) * kmax;
    }
    volatile LAS int* flags = (volatile LAS int*)(lds + A_FLAG);
    f32x16 o0, o1;
#pragma unroll
    for (int i = 0; i < 16; ++i) { o0[i] = 0.f; o1[i] = 0.f; }
    float mrun = -1e30f, lrun = 0.f, Rc = 1.f;
    u32x4 krA, vrA, krB, vrB; f32x4 kfA[2], vfA[2], kfB[2], vfB[2];
    const int srow = tid >> 3, sch = tid & 7;
#define ATT_LOAD(kt, X) do { if constexpr (F32) { _Pragma("unroll") for (int i_ = 0; i_ < 2; ++i_) { const int idx_ = tid + 512 * i_, row_ = idx_ >> 4, c4_ = idx_ & 15, key_ = (kt) * 64 + row_; \
            const float* kp_ = key_ < ksplit ? (const float*)K1 + (size_t)key_ * ld1 : K2 + (size_t)(key_ - ksplit) * ld1; \
            const float* vp_ = key_ < ksplit ? (const float*)V1 + (size_t)key_ * ld1 : V2 + (size_t)(key_ - ksplit) * ld1; \
            kf##X[i_] = *(const f32x4*)(kp_ + c4_ * 4); vf##X[i_] = *(const f32x4*)(vp_ + c4_ * 4); } } \
        else { kr##X = *(const u32x4*)((const bf16_t*)K1 + ((size_t)(kt) * 64 + srow) * HD + sch * 8); vr##X = *(const u32x4*)((const bf16_t*)V1 + ((size_t)(kt) * 64 + srow) * HD + sch * 8); } } while (0)
#define ATT_STORE(buf, X) do { LAS unsigned char* ks_ = lds + A_KS + (buf) * 64 * KPITCH; LAS unsigned char* vs_ = lds + A_VS + (buf) * 64 * VPITCH; \
        if constexpr (F32) { _Pragma("unroll") for (int i_ = 0; i_ < 2; ++i_) { const int idx_ = tid + 512 * i_, row_ = idx_ >> 4, c4_ = idx_ & 15; \
            *(LAS u32x2*)(ks_ + row_ * KPITCH + c4_ * 8) = pack4(kf##X[i_]); *(LAS u32x2*)(vs_ + row_ * VPITCH + c4_ * 8) = pack4(vf##X[i_]); } } \
        else { *(LAS u32x4*)(ks_ + srow * KPITCH + sch * 16) = kr##X; *(LAS u32x4*)(vs_ + srow * VPITCH + sch * 16) = vr##X; } } while (0)
#define ATT_STEP(IT, LD, ST) { const int it_ = (IT), kt = ntile - 1 - it_, buf = it_ & 1; \
        if (prune && it_ > 0) { volatile LAS int* fl = flags + ((it_ - 1) & 1) * 8; const int all_ = fl[0] & fl[1] & fl[2] & fl[3] & fl[4] & fl[5] & fl[6] & fl[7]; if (all_) break; } \
        if (it_ + 2 < ntile) ATT_LOAD(kt - 2, LD); \
        if (active && !(causal && 64 * kt > qmax)) \
            att_tile<SB>(lds + A_KS + buf * 64 * KPITCH, lds + A_VS + buf * 64 * VPITCH, kt, c2, h, r, qf, causal && (64 * kt + 63 >= qmin), qpos, mrun, lrun, Rc, o0, o1); \
        if (prune && kt > 0) { \
            bool done = true; \
            if (active) { \
                if constexpr (SB) done = __all(Rc < 2.3283064e-10f);   \
                else { const int kn = 64 * kt - 1; done = (kn < qmin) && __all(qn - c2[kn] < mrun - THR_FOX); } \
            } \
            if (lane == 0) flags[(it_ & 1) * 8 + wid] = done ? 1 : 0; \
        } \
        if (it_ + 1 < ntile) ATT_STORE(buf ^ 1, ST); \
        __syncthreads(); }
    ATT_LOAD(ntile - 1, A);
    if (csA) fox_cumsum((LAS float*)c2, (LAS float*)(lds + A_SCAN), csA, cs_split, csB, cs_n);
    ATT_STORE(0, A);
    if (ntile > 1) ATT_LOAD(ntile - 2, A);
    __syncthreads();
    for (int it = 0; it < ntile; it += 2) {
        ATT_STEP(it, B, A)
        if (it + 1 >= ntile) break;
        ATT_STEP(it + 1, A, B)
    }
#undef ATT_STEP
#undef ATT_LOAD
#undef ATT_STORE
    if (active) {
        float inv = 1.f;
        if constexpr (!SB) { const float lt = lrun + __shfl_xor(lrun, 32); inv = 1.f / lt; }
        bf16_t* orow = O + (size_t)(wid * 32 + r) * DM;
#pragma unroll
        for (int g = 0; g < 4; ++g) {
            f32x4 a = (f32x4){o0[4 * g], o0[4 * g + 1], o0[4 * g + 2], o0[4 * g + 3]} * inv, b = (f32x4){o1[4 * g], o1[4 * g + 1], o1[4 * g + 2], o1[4 * g + 3]} * inv;
            *(u32x2*)(orow + 8 * g + 4 * h) = pack4(a); *(u32x2*)(orow + 32 + 8 * g + 4 * h) = pack4(b);
        }
    }
}

#define XB_TMO      128
#define XB_XCNT(j)  (256  + 64 * (j))
#define XB_XSUB(j)  (1280 + 64 * (j))
#define XB_XGEN(j)  (2304 + 64 * (j))
#define XB_TOP      3328
#define XB_TOPGEN   3392
#define XCD_BAR_WORDS 3456
#define XB_SPIN_CAP (1u << 18)
__device__ __forceinline__ unsigned xb_ld(unsigned* p)              { return __hip_atomic_load(p, __ATOMIC_RELAXED, __HIP_MEMORY_SCOPE_AGENT); }
__device__ __forceinline__ unsigned xb_add(unsigned* p, unsigned v) { return __hip_atomic_fetch_add(p, v, __ATOMIC_RELAXED, __HIP_MEMORY_SCOPE_AGENT); }
__device__ __forceinline__ unsigned xb_xcc_id() { return (unsigned)__builtin_amdgcn_s_getreg((3 << 11) | 20) & 0xFu; }
#define XB_SPIN(cond, bar) do { unsigned _sp = 0; while (cond) { __builtin_amdgcn_s_sleep(1); \
    if ((++_sp & 255u) == 0u) { if (xb_ld(&(bar)[XB_TMO])) break; if (_sp > XB_SPIN_CAP) { atomicAdd(&(bar)[XB_TMO], 1u); break; } } } } while (0)
struct XcdBarrier { unsigned* bar; unsigned x; volatile LAS unsigned* st; };
__device__ __forceinline__ XcdBarrier xcd_barrier_post(unsigned* bar, volatile LAS unsigned* st) {
    XcdBarrier b; b.bar = bar; b.x = xb_xcc_id(); b.st = st;
    if (threadIdx.x == 0) (void)xb_add(&bar[XB_XCNT(b.x)], 1u);
    return b;
}
__device__ __forceinline__ void xcd_barrier_complete(unsigned* bar, unsigned x, unsigned& nloc, unsigned& nx) {
    const unsigned G = gridDim.x * gridDim.y * gridDim.z;
    unsigned sum, cnt, mine, sp = 0u;
    for (;;) {
        sum = 0u; cnt = 0u; mine = 0u;
#pragma unroll
        for (unsigned j = 0; j < 16; ++j) { const unsigned c = xb_ld(&bar[XB_XCNT(j)]); sum += c; cnt += (c > 0u) ? 1u : 0u; mine = (j == x) ? c : mine; }
        if (sum == G) break;
        __builtin_amdgcn_s_sleep(1);
        if ((++sp & 255u) == 0u) { if (xb_ld(&bar[XB_TMO])) break; if (sp > XB_SPIN_CAP) { atomicAdd(&bar[XB_TMO], 1u); break; } }
    }
    nloc = mine > 0u ? mine : 1u; nx = cnt > 0u ? cnt : 1u;
}
__device__ __forceinline__ void xcd_barrier(const XcdBarrier& b) {
    asm volatile("s_waitcnt vmcnt(0)" ::: "memory");
    __syncthreads();
    if (threadIdx.x == 0) {
        unsigned* bar = b.bar;
        __builtin_amdgcn_s_waitcnt(0);
        unsigned nloc = b.st[0], nx = b.st[1];
        if (nloc == 0u) { xcd_barrier_complete(bar, b.x, nloc, nx); b.st[0] = nloc; b.st[1] = nx; }
        const unsigned old = xb_add(&bar[XB_XSUB(b.x)], 1u);
        const unsigned gen = old / nloc;
        if (old + 1u == (gen + 1u) * nloc) {
            __builtin_amdgcn_fence(__ATOMIC_RELEASE, "agent");
            asm volatile("s_waitcnt vmcnt(0)" ::: "memory");
            const unsigned og = xb_add(&bar[XB_TOP], 1u);
            const unsigned tg = og / nx;
            if (og + 1u == (tg + 1u) * nx) xb_add(&bar[XB_TOPGEN], 1u);
            else XB_SPIN(xb_ld(&bar[XB_TOPGEN]) == tg, bar);
            __builtin_amdgcn_fence(__ATOMIC_ACQUIRE, "agent");
            xb_add(&bar[XB_XGEN(b.x)], 1u);
            asm volatile("s_waitcnt vmcnt(0)" ::: "memory");
        } else {
            XB_SPIN(xb_ld(&bar[XB_XGEN(b.x)]) == gen, bar);
            __builtin_amdgcn_fence(__ATOMIC_ACQUIRE, "agent");
            asm volatile("s_waitcnt vmcnt(0)" ::: "memory");
        }
    }
    __syncthreads();
}

struct Params { const float* in[21]; float* out; unsigned char* ws; int ph_lo, ph_hi; };
constexpr int LDS_BYTES = pg8::STAGE_BYTES + 4096;
constexpr int N_PHASES = 22;

__global__ void __launch_bounds__(512, 2) mega(Params p) {
    extern __shared__ __attribute__((aligned(16))) unsigned char lds_raw[];
    LAS unsigned char* lds = (LAS unsigned char*)lds_raw;
    const int tid = threadIdx.x, lane = tid & 63, wave = __builtin_amdgcn_readfirstlane(tid >> 6);
    const int G = gridDim.x, bid = blockIdx.x;
    const int lo = p.ph_lo, hi = p.ph_hi;
#define IN(k) (lo <= (k) && (k) < hi)
    volatile LAS unsigned* MISC = (volatile LAS unsigned*)(lds + pg8::STAGE_BYTES);
    if (tid < 2) MISC[tid] = 0u;
    __syncthreads();
    XcdBarrier xbar; xbar.bar = (unsigned*)(p.ws + WS_BAR); xbar.x = 0; xbar.st = MISC;
    if (ONE_LAUNCH) xbar = xcd_barrier_post((unsigned*)(p.ws + WS_BAR), MISC);
#define SEAM(k) do { if (IN(k) && IN((k) + 1)) { xcd_barrier(xbar); if (DUP & 64) { xcd_barrier(xbar); xcd_barrier(xbar); } } } while (0)
    if (lo < 0) cg::this_grid().sync();
#define WSP(T, off) ((T*)(p.ws + (off)))

    if (IN(0) && !NO_P0) for (int rep0 = 0; rep0 < ((DUP & 1) ? 2 : 1); ++rep0) {
        if (bid == 0 && tid < 16) WSP(unsigned, WS_CTR)[tid] = 0u;
        if (rep0 == 0) {
            const int gw_ = bid * 8 + wave; const float* ck = p.in[3];
            for (int ch = gw_; ch < 2 * NB * PAST / 16; ch += G * 8) {
                const float* rp = ck + (size_t)ch * 16 * MIXW; float mx[3] = {0.f, 0.f, 0.f};
#pragma unroll 4
                for (int rr = 0; rr < 16; ++rr) {
#pragma unroll
                    for (int i = 0; i < 3; ++i) { const f32x4 v = *(const f32x4*)(rp + (size_t)rr * MIXW + i * 256 + lane * 4); float q2 = (v[0] * v[0] + v[1] * v[1]) + (v[2] * v[2] + v[3] * v[3]);
                        q2 += __shfl_xor(q2, 1); q2 += __shfl_xor(q2, 2); q2 += __shfl_xor(q2, 4); q2 += __shfl_xor(q2, 8); mx[i] = fmaxf(mx[i], q2); }
                }
                const int jb = ch / (PAST / 16);
                if ((lane & 15) == 0) {
#pragma unroll
                    for (int i = 0; i < 3; ++i) atomicMax(WSP(unsigned, WS_KNMAX) + 384 + jb * NH + i * 4 + (lane >> 4), __float_as_uint(mx[i]));
                }
            }
        }
        LAS float* scr = (LAS float*)(lds + wave * 16384);
        const int gw = bid * 8 + wave, NGW = G * 8;
        constexpr int I_IN = 4 * 16 * 88, I_OUT = 4 * 16 * 32, I_GU = 4 * 16 * 176, I_DN = 4 * 44 * 32, I_MKV = 4 * 16 * 16;
        constexpr int NITEMS = I_IN + I_OUT + I_GU + I_DN + I_MKV;
        for (int it = gw; it < NITEMS; it += NGW) {
            int r = it;
            if (r < I_IN) {
                const int L = r / 1408; r %= 1408; const int kb = r / 88, nb = r % 88; const bool fox = !(L & 1); const int j = L >> 1;
                const float* W = fox ? p.in[11] + (size_t)j * DM * 2572 : p.in[13] + (size_t)j * DM * 2560; const int ldw = fox ? 2572 : 2560;
                const int n0 = nb * 32; int srccol, nvalid = 32;
                if (n0 < 2304) srccol = n0;
                else if (n0 < 2560) srccol = (fox ? 2316 : 2304) + (n0 - 2304);
                else { if (!fox) continue; if (nb == 80) { srccol = 2304; nvalid = 12; } else { srccol = 0; nvalid = 0; } }
                tr_item(W + (size_t)kb * 64 * ldw + srccol, ldw, p.in[10] + L * DM + kb * 64, WSP(bf16_t, WS_WIN) + (size_t)L * NIN_PAD * DM + (size_t)n0 * DM + kb * 64, DM, nvalid, scr, lane);
                continue;
            }
            r -= I_IN;
            if (r < I_OUT) {
                const int L = r / 512; r %= 512; const int kb = r / 32, nb = r % 32;
                tr_item(p.in[16] + (size_t)L * DM * DM + (size_t)kb * 64 * DM + nb * 32, DM, nullptr, WSP(bf16_t, WS_WOUT) + (size_t)L * DM * DM + (size_t)nb * 32 * DM + kb * 64, DM, 32, scr, lane);
                continue;
            }
            r -= I_OUT;
            if (r < I_GU) {
                const int L = r / 2816; r %= 2816; const int kb = r / 176, nb = r % 176; const int pn = nb >> 3, bj = (nb & 7) >> 2, cb = nb & 3;
                const int srccol = bj * DFF + pn * 128 + cb * 32;
                tr_item(p.in[18] + (size_t)L * DM * 2 * DFF + (size_t)kb * 64 * 2 * DFF + srccol, 2 * DFF, p.in[17] + L * DM + kb * 64, WSP(bf16_t, WS_WGU) + (size_t)L * 2 * DFF * DM + (size_t)nb * 32 * DM + kb * 64, DM, 32, scr, lane);
                continue;
            }
            r -= I_GU;
            if (r < I_DN) {
                const int L = r / 1408; r %= 1408; const int kb = r / 32, nb = r % 32;
                tr_item(p.in[19] + (size_t)L * DFF * DM + (size_t)kb * 64 * DM + nb * 32, DM, nullptr, WSP(bf16_t, WS_WDN) + (size_t)L * DM * DFF + (size_t)nb * 32 * DFF + kb * 64, DFF, 32, scr, lane);
                continue;
            }
            r -= I_DN;
            {
                const int L = r / 256; r %= 256; const int kb = r / 16, nb = r % 16;
                tr_item(p.in[15] + (size_t)L * DM * 512 + (size_t)kb * 64 * 512 + nb * 32, 512, p.in[14] + L * DM + kb * 64, WSP(bf16_t, WS_WMKV) + (size_t)L * 512 * DM + (size_t)nb * 32 * DM + kb * 64, DM, 32, scr, lane);
            }
        }
        for (int rowa = gw; rowa < MTOT + NB * NMEM; rowa += 2 * NGW) {
            f32x4 v[2][4]; const float* src[2]; bf16_t* dst[2]; bool ok[2], ismem[2]; int rw[2];
#pragma unroll
            for (int q = 0; q < 2; ++q) { const int row = rowa + q * NGW; rw[q] = row; ok[q] = row < MTOT + NB * NMEM; ismem[q] = row >= MTOT;
                src[q] = ismem[q] ? p.in[2] + (size_t)(row - MTOT) * DM : (row < MP ? p.in[0] + (size_t)row * DM : p.in[1] + (size_t)(row - MP) * DM);
                dst[q] = ismem[q] ? WSP(bf16_t, WS_MPB) + (size_t)(row - MTOT) * DM : WSP(bf16_t, WS_XB) + (size_t)row * DM;
#pragma unroll
                for (int j = 0; j < 4; ++j) v[q][j] = ok[q] ? *(const f32x4*)(src[q] + j * 256 + lane * 4) : (f32x4){0.f, 0.f, 0.f, 0.f}; }
#pragma unroll
            for (int q = 0; q < 2; ++q) if (ok[q]) {
                float ss = 0.f;
#pragma unroll
                for (int j = 0; j < 4; ++j) { const f32x4 w = v[q][j]; ss += (w[0] * w[0] + w[1] * w[1]) + (w[2] * w[2] + w[3] * w[3]); *(u32x2*)(dst[q] + j * 256 + lane * 4) = pack4(w); }
                ss = wave_sum(ss);
                if (ismem[q]) { if (lane == 0) WSP(float, WS_RSTDM)[rw[q] - MTOT] = rsqrtf(ss * (1.0f / DM) + EPS); }
                else if (lane < 16) WSP(float, WS_SSQA)[(size_t)rw[q] * 16 + lane] = (lane == 0) ? ss : 0.f;
            }
        }
        __syncthreads();
    }
    SEAM(0);

#pragma unroll 1
    for (int L = 0; L < 4; ++L) {
        const bool fox = !(L & 1); const int j = L >> 1; const int P0 = 1 + 5 * L;
        if (IN(P0) && !NO_PIN) {
            const int N = fox ? NIN_PAD : 2560;
            { pg8::Gemm g{WSP(bf16_t, WS_XB), WSP(bf16_t, WS_WIN) + (size_t)L * NIN_PAD * DM, MTOT, N, DM}; pg8::StaticOrder S; S.init(MTOT, N, G, bid);
              EpiIn E{p.ws, p.out, p.in[12] + j * NH, fox ? 1 : 0, j};
              if (DUP & 2) pg8::gemm_phase<EpiIn, pg8::StaticOrder, true, SP2V>(lds, g, S, E);
              pg8::gemm_phase<EpiIn, pg8::StaticOrder, true, SP2V>(lds, g, S, E); }
            if (L < 2) {
                const int nl = (L == 0) ? 1 : 3, l0 = (L == 0) ? 0 : 1; const int rot = ((MTOT / 256) * (N / 256)) % G;
                pg8::Gemm g{WSP(bf16_t, WS_MPB), WSP(bf16_t, WS_WMKV) + (size_t)l0 * 512 * DM, NB * NMEM, nl * 512, DM}; pg8::StaticOrder S; S.init(NB * NMEM, nl * 512, G, (bid + G - rot) % G);
                EpiMKV E{p.ws, p.out, l0};
                pg8::gemm_phase<EpiMKV, pg8::StaticOrder, true, SP2V>(lds, g, S, E);
            }
        }
        SEAM(P0);
        if (IN(P0 + 1) && !NO_ATT) {
            LAS float* c2 = (LAS float*)(lds + A_C2); LAS float* scan = (LAS float*)(lds + A_SCAN); volatile LAS int* su = (volatile LAS int*)(lds + A_UNIT);
            constexpr int U_S = NB * NH, U_P = NB * NH * 8, U_MP = NB * NMH * 8, U_MS = NB * NMH, U_TOT = U_S + U_P + U_MP + U_MS;
            float* out = p.out;
            float* ok_s = out + (fox ? O_FKS : O_SKS) + (size_t)j * KVS_L; float* ov_s = out + (fox ? O_FVS : O_SVS) + (size_t)j * KVS_L;
            float* olf_p = out + O_FLP + (size_t)j * MP * NH; float* olf_s = out + O_FLS + (size_t)j * MS * NH;
            bf16_t* OB = WSP(bf16_t, WS_OB);
            for (int rep = 0; rep < ((DUP & 4) ? 2 : 1); ++rep) {
            for (;;) {
                if (tid == 0) su[0] = (int)atomicAdd(WSP(unsigned, WS_CTR) + L + 4 * rep, 1u);
                __syncthreads();
                const int un = su[0];
                __syncthreads();
                if (un >= U_TOT) break;
                if (un < U_S) {
                    const int bh = un, b = bh / NH, h = bh % NH;
                    const float* K1 = (fox ? p.in[3] : p.in[6]) + (size_t)j * NB * PAST * MIXW + (size_t)b * PAST * MIXW + h * HD;
                    const float* V1 = (fox ? p.in[4] : p.in[7]) + (size_t)j * NB * PAST * MIXW + (size_t)b * PAST * MIXW + h * HD;
                    const float* K2 = ok_s + (size_t)b * DSEQ * MIXW + h * HD; const float* V2 = ov_s + (size_t)b * DSEQ * MIXW + h * HD;
                    bf16_t* O = OB + (size_t)(MP + b * DSEQ) * DM + h * HD;
                    const bf16_t* Q = WSP(bf16_t, WS_QHS) + (size_t)bh * DSEQ * HD;
                    if (fox) {
                        float n2 = 0.f;
                        { const float* kr = K2 + (size_t)(tid & 63) * MIXW;
#pragma unroll
                          for (int i = 0; i < 16; ++i) { const f32x4 v = *(const f32x4*)(kr + i * 4); n2 += (v[0] * v[0] + v[1] * v[1]) + (v[2] * v[2] + v[3] * v[3]); }
#pragma unroll
                          for (int o_ = 1; o_ < 64; o_ <<= 1) n2 = fmaxf(n2, __shfl_xor(n2, o_)); }
                        const float kmax = sqrtf(fmaxf(n2, __uint_as_float(WSP(unsigned, WS_KNMAX)[384 + (j * NB + b) * NH + h]))) * 1.01f;
                        attn_unit<false, true>(lds, Q, DSEQ, PAST, K1, V1, MIXW, K2, V2, PAST, (PAST + DSEQ) / 64, true, c2, O, kmax,
                                               p.in[5] + (size_t)j * NB * PAST * NH + (size_t)b * PAST * NH + h, PAST, olf_s + (size_t)b * DSEQ * NH + h, PAST + DSEQ); }
                    else attn_unit<true, true>(lds, Q, DSEQ, PAST, K1, V1, MIXW, K2, V2, PAST, (PAST + DSEQ) / 64, true, nullptr, O, -1.f);
                } else if (un < U_S + U_P) {
                    const int k = un - U_S, qt = 7 - k / (NB * NH), bh = k % (NB * NH), b = bh / NH, h = bh % NH;
                    const bf16_t* Q = WSP(bf16_t, WS_QHP) + ((size_t)bh * SEQ + qt * 256) * HD; const bf16_t* K1 = WSP(bf16_t, WS_KH) + (size_t)bh * SEQ * HD; const bf16_t* V1 = WSP(bf16_t, WS_VT) + (size_t)bh * SEQ * HD;
                    bf16_t* O = OB + (size_t)(b * SEQ + qt * 256) * DM + h * HD;
                    if (fox) {
                        const unsigned* kq = WSP(unsigned, WS_KNMAX) + ((size_t)j * NB * NH + bh) * 2;
                        const float kmax = sqrtf(__uint_as_float(kq[0]) + __uint_as_float(kq[1])) * 1.01f;
                        attn_unit<false, false>(lds, Q, 256, qt * 256, K1, V1, SEQ, nullptr, nullptr, 1 << 30, 4 * (qt + 1), true, c2, O, kmax, olf_p + (size_t)b * SEQ * NH + h, 1 << 30, nullptr, 256 * (qt + 1)); }
                    else attn_unit<true, false>(lds, Q, 256, qt * 256, K1, V1, SEQ, nullptr, nullptr, 1 << 30, 4 * (qt + 1), true, nullptr, O, -1.f);
                } else if (un < U_S + U_P + U_MP) {
                    const int k = un - U_S - U_P, bm = k >> 3, qt = k & 7, b = bm >> 2, mh = bm & 3;
                    attn_unit<false, false>(lds, WSP(bf16_t, WS_QMP) + ((size_t)bm * SEQ + qt * 256) * HD, 256, 0, WSP(bf16_t, WS_MKB) + (size_t)(L * NB * NMH + bm) * NMEM * HD, WSP(bf16_t, WS_MVT) + (size_t)(L * NB * NMH + bm) * NMEM * HD, NMEM,
                                            nullptr, nullptr, 1 << 30, NMEM / 64, false, nullptr, OB + (size_t)(b * SEQ + qt * 256) * DM + MIXW + mh * HD, -1.f);
                } else {
                    const int bm = un - U_S - U_P - U_MP, b = bm >> 2, mh = bm & 3;
                    attn_unit<false, true>(lds, WSP(bf16_t, WS_QMS) + (size_t)bm * DSEQ * HD, DSEQ, 0, p.in[8] + ((size_t)(L * NB + b) * NMEM * NMH + mh) * HD, p.in[9] + ((size_t)(L * NB + b) * NMEM * NMH + mh) * HD, NMH * HD,
                                           nullptr, nullptr, 1 << 30, NMEM / 64, false, nullptr, OB + (size_t)(MP + b * DSEQ) * DM + MIXW + mh * HD, -1.f);
                }
            }
            }
        }
        SEAM(P0 + 1);
        if (IN(P0 + 2) && !NO_POUT) {
            pg8::Gemm g{WSP(bf16_t, WS_OB), WSP(bf16_t, WS_WOUT) + (size_t)L * DM * DM, MP, DM, DM}; pg8::StaticOrder S; S.init(MP, DM, G, bid);
            if (DUP & 8) { EpiRes E2{p.ws, WS_DSSQ, WS_DXB}; pg8::gemm_phase<EpiRes, pg8::StaticOrder, true, SP2V>(lds, g, S, E2); }
            EpiRes E{p.ws, WS_SSQB, WS_XB};
            pg8::gemm_phase<EpiRes, pg8::StaticOrder, true, SP2V>(lds, g, S, E);
            for (int tile = bid; tile < 256; tile += G)
                small_res_gemm(lds, WSP(bf16_t, WS_OB) + (size_t)MP * DM, WSP(bf16_t, WS_WOUT) + (size_t)L * DM * DM, DM, WSP(bf16_t, WS_XB) + (size_t)MP * DM, WSP(float, WS_SSQB) + (size_t)MP * 16, tile);
        }
        SEAM(P0 + 2);
        if (IN(P0 + 3) && !NO_PGU) {
            pg8::Gemm g{WSP(bf16_t, WS_XB), WSP(bf16_t, WS_WGU) + (size_t)L * 2 * DFF * DM, MTOT, 2 * DFF, DM}; pg8::StaticOrder S; S.init(MTOT, 2 * DFF, G, bid);
            EpiGU E{p.ws};
            if (DUP & 16) pg8::gemm_phase<EpiGU, pg8::StaticOrder, true, SP2V>(lds, g, S, E);
            pg8::gemm_phase<EpiGU, pg8::StaticOrder, true, SP2V>(lds, g, S, E);
        }
        SEAM(P0 + 3);
        if (IN(P0 + 4) && !NO_PDN) {
            pg8::Gemm g{WSP(bf16_t, WS_ACT), WSP(bf16_t, WS_WDN) + (size_t)L * DM * DFF, MP, DM, DFF}; pg8::StaticOrder S; S.init(MP, DM, G, bid);
            if (DUP & 32) { EpiRes E2{p.ws, WS_DSSQ, WS_DXB}; pg8::gemm_phase<EpiRes, pg8::StaticOrder, true, SP2V>(lds, g, S, E2); }
            EpiRes E{p.ws, WS_SSQA, WS_XB};
            pg8::gemm_phase<EpiRes, pg8::StaticOrder, true, SP2V>(lds, g, S, E);
            for (int tile = bid; tile < 256; tile += G)
                small_res_gemm(lds, WSP(bf16_t, WS_ACT) + (size_t)MP * DFF, WSP(bf16_t, WS_WDN) + (size_t)L * DM * DFF, DFF, WSP(bf16_t, WS_XB) + (size_t)MP * DM, WSP(float, WS_SSQA) + (size_t)MP * 16, tile);
        }
        SEAM(P0 + 4);
    }
    if (IN(21)) {
        const int gw = bid * 8 + wave, NGW = G * 8;
        const bf16_t* XB = WSP(bf16_t, WS_XB); const float* g_final = p.in[20]; float* out = p.out;
        for (int row0 = gw; row0 < MTOT; row0 += 2 * NGW) {
            const int row1 = row0 + NGW; const bool has1 = row1 < MTOT;
            const float rs0 = rstd16(WSP(float, WS_SSQA), row0), rs1 = has1 ? rstd16(WSP(float, WS_SSQA), row1) : 0.f;
            u32x2 x0[4], x1[4];
#pragma unroll
            for (int j = 0; j < 4; ++j) { x0[j] = *(const u32x2*)(XB + (size_t)row0 * DM + j * 256 + lane * 4); x1[j] = has1 ? *(const u32x2*)(XB + (size_t)row1 * DM + j * 256 + lane * 4) : (u32x2){0u, 0u}; }
#pragma unroll
            for (int j = 0; j < 4; ++j) { const int c = j * 256 + lane * 4; const f32x4 gv = *(const f32x4*)(g_final + c);
                *(f32x4*)(out + (size_t)row0 * DM + c) = unpack4(x0[j]) * rs0 * gv;
                if (has1) *(f32x4*)(out + (size_t)row1 * DM + c) = unpack4(x1[j]) * rs1 * gv; }
        }
    }
#undef IN
#undef SEAM
#undef WSP
}

extern "C" void kernel_launch(void* const* d_in, const int* in_sizes, int n_in, void* d_out, int out_size, void* d_ws, size_t ws_size, hipStream_t stream) {
    static int grid = 0;
    if (grid == 0) {
        if (n_in != 21 || (size_t)out_size != O_END || ws_size < (DUP ? WS_DEND : WS_END)) { fprintf(stderr, "kernel_launch: unexpected sizes n_in %d out %d ws %zu (need %zu)\n", n_in, out_size, ws_size, (size_t)WS_END); grid = -1; return; }
        int dev = 0, cus = 0, per_cu = 0;
        hipGetDevice(&dev); hipDeviceGetAttribute(&cus, hipDeviceAttributeMultiprocessorCount, dev);
        if (hipFuncSetAttribute((const void*)mega, hipFuncAttributeMaxDynamicSharedMemorySize, LDS_BYTES) != hipSuccess) { fprintf(stderr, "kernel_launch: hipFuncSetAttribute failed\n"); grid = -1; return; }
        if (hipOccupancyMaxActiveBlocksPerMultiprocessor(&per_cu, (const void*)mega, 512, LDS_BYTES) != hipSuccess || per_cu < 1) { fprintf(stderr, "kernel_launch: occupancy query says %d\n", per_cu); per_cu = 1; }
        (void)hipGetLastError();
        grid = cus * 1;
    }
    if (grid < 0) return;
    Params p{};
    for (int i = 0; i < 21; ++i) p.in[i] = (const float*)d_in[i];
    p.out = (float*)d_out; p.ws = (unsigned char*)d_ws;
#if ONE_LAUNCH
    if (hipMemsetAsync((char*)d_ws + WS_KNMAX, 0, (WS_BAR - WS_KNMAX) + 16384, stream) != hipSuccess) { fprintf(stderr, "kernel_launch: memset failed\n"); return; }
    p.ph_lo = 0; p.ph_hi = N_PHASES;
    void* args[] = {&p};
    hipError_t e = hipLaunchCooperativeKernel((void*)mega, dim3(grid), dim3(512), args, LDS_BYTES, stream);
    if (e != hipSuccess) fprintf(stderr, "cooperative launch failed: %s (grid %d)\n", hipGetErrorString(e), grid);
#else
    for (int ph = 0; ph < N_PHASES; ++ph) {
        p.ph_lo = ph; p.ph_hi = ph + 1;
        hipLaunchKernelGGL(mega, dim3(grid), dim3(512), LDS_BYTES, stream, p);
    }
#endif
}
```

```cpp
#include <hip/hip_runtime.h>
#include <hip/hip_cooperative_groups.h>
#include <cstdio>
#include <cstdint>
namespace cg = cooperative_groups;

#ifndef ONE_LAUNCH
#define ONE_LAUNCH 1
#endif

#ifndef SP2V
#define SP2V true
#endif
#ifndef DUP
#define DUP 0
#endif
#ifndef NO_PIN
#define NO_PIN 0
#endif
#ifndef NO_ATT
#define NO_ATT 0
#endif
#ifndef NO_POUT
#define NO_POUT 0
#endif
#ifndef NO_PGU
#define NO_PGU 0
#endif
#ifndef NO_PDN
#define NO_PDN 0
#endif
#ifndef NO_P0
#define NO_P0 0
#endif
#define LAS __attribute__((address_space(3)))
typedef unsigned short bf16_t;
typedef short bf16x8 __attribute__((ext_vector_type(8)));
typedef short s16x4 __attribute__((ext_vector_type(4)));
typedef float f32x4 __attribute__((ext_vector_type(4)));
typedef float f32x16 __attribute__((ext_vector_type(16)));
typedef unsigned u32x4 __attribute__((ext_vector_type(4)));
typedef unsigned u32x2 __attribute__((ext_vector_type(2)));

constexpr int DM = 1024, SEQ = 2048, NB = 8, DSEQ = 64, PAST = 2048, NH = 12, HD = 64, NMH = 4, NMEM = 256, DFF = 2816;
constexpr int MP = NB * SEQ;
constexpr int MS = NB * DSEQ;
constexpr int MTOT = MP + MS;
constexpr int MIXW = 768;
constexpr int NIN_PAD = 2816;
constexpr float EPS = 1e-6f;
constexpr float LOG2E = 1.4426950408889634f;
constexpr float QSCALE = 0.125f * LOG2E;

constexpr size_t O_YP = 0;
constexpr size_t O_YS = O_YP + (size_t)MP * DM;
constexpr size_t O_FKP = O_YS + (size_t)MS * DM;
constexpr size_t KVP_L = (size_t)MP * MIXW;
constexpr size_t O_FVP = O_FKP + 2 * KVP_L;
constexpr size_t O_FLP = O_FVP + 2 * KVP_L;
constexpr size_t O_SKP = O_FLP + 2 * (size_t)MP * NH;
constexpr size_t O_SVP = O_SKP + 2 * KVP_L;
constexpr size_t O_MKP = O_SVP + 2 * KVP_L;
constexpr size_t MKV_L = (size_t)NB * NMEM * 256;
constexpr size_t O_MVP = O_MKP + 4 * MKV_L;
constexpr size_t O_FKS = O_MVP + 4 * MKV_L;
constexpr size_t KVS_L = (size_t)MS * MIXW;
constexpr size_t O_FVS = O_FKS + 2 * KVS_L;
constexpr size_t O_FLS = O_FVS + 2 * KVS_L;
constexpr size_t O_SKS = O_FLS + 2 * (size_t)MS * NH;
constexpr size_t O_SVS = O_SKS + 2 * KVS_L;
constexpr size_t O_END = O_SVS + 2 * KVS_L;

constexpr size_t al256(size_t x) { return (x + 255) & ~(size_t)255; }
constexpr size_t WS_CTR = 0;
constexpr size_t WS_KNMAX = 2048;
constexpr size_t WS_BAR = 4096;
constexpr size_t WS_WIN = 32768;
constexpr size_t WS_WOUT = WS_WIN + (size_t)4 * NIN_PAD * DM * 2;
constexpr size_t WS_WGU = WS_WOUT + (size_t)4 * DM * DM * 2;
constexpr size_t WS_WDN = WS_WGU + (size_t)4 * 2 * DFF * DM * 2;
constexpr size_t WS_WMKV = WS_WDN + (size_t)4 * DM * DFF * 2;
constexpr size_t WS_XB = WS_WMKV + (size_t)4 * 512 * DM * 2;
constexpr size_t WS_XF = WS_XB + (size_t)MTOT * DM * 2;
constexpr size_t WS_QHP = WS_XF + (size_t)MTOT * DM * 4;
constexpr size_t WS_QHS = WS_QHP + (size_t)NB * NH * SEQ * HD * 2;
constexpr size_t WS_QMP = WS_QHS + (size_t)NB * NH * DSEQ * HD * 2;
constexpr size_t WS_QMS = WS_QMP + (size_t)NB * NMH * SEQ * HD * 2;
constexpr size_t WS_KH = WS_QMS + (size_t)NB * NMH * DSEQ * HD * 2;
constexpr size_t WS_VT = WS_KH + (size_t)NB * NH * SEQ * HD * 2;
constexpr size_t WS_OB = WS_VT + (size_t)NB * NH * SEQ * HD * 2;
constexpr size_t WS_ACT = WS_OB + (size_t)MTOT * DM * 2;
constexpr size_t WS_MPB = WS_ACT + (size_t)MTOT * DFF * 2;
constexpr size_t WS_MKB = WS_MPB + (size_t)NB * NMEM * DM * 2;
constexpr size_t WS_MVT = WS_MKB + (size_t)4 * NB * NMH * NMEM * HD * 2;
constexpr size_t WS_SSQA = WS_MVT + (size_t)4 * NB * NMH * NMEM * HD * 2;
constexpr size_t WS_SSQB = WS_SSQA + (size_t)MTOT * 16 * 4;
constexpr size_t WS_RSTDM = WS_SSQB + (size_t)MTOT * 16 * 4;
constexpr size_t WS_END = al256(WS_RSTDM + (size_t)NB * NMEM * 4);
constexpr size_t WS_DXF = WS_END, WS_DXB = WS_DXF + (size_t)MTOT * DM * 4, WS_DSSQ = WS_DXB + (size_t)MTOT * DM * 2, WS_DEND = WS_DSSQ + (size_t)MTOT * 16 * 4;

typedef float f32x2_t __attribute__((ext_vector_type(2))); typedef __bf16 bf16x2_t __attribute__((ext_vector_type(2)));
__device__ __forceinline__ unsigned cvt_pk_bf16(float lo, float hi) { const f32x2_t v = {lo, hi}; const bf16x2_t b = __builtin_convertvector(v, bf16x2_t); return __builtin_bit_cast(unsigned, b); }
__device__ __forceinline__ u32x2 pack4(f32x4 v) { u32x2 w; w.x = cvt_pk_bf16(v[0], v[1]); w.y = cvt_pk_bf16(v[2], v[3]); return w; }
__device__ __forceinline__ u32x4 pack8(f32x4 a, f32x4 b) { u32x4 w; w.x = cvt_pk_bf16(a[0], a[1]); w.y = cvt_pk_bf16(a[2], a[3]); w.z = cvt_pk_bf16(b[0], b[1]); w.w = cvt_pk_bf16(b[2], b[3]); return w; }
__device__ __forceinline__ bf16_t f2bf(float f) { unsigned u = __builtin_bit_cast(unsigned, f); return (bf16_t)((u + 0x7fffu + ((u >> 16) & 1u)) >> 16); }

namespace pg8 {
#define PG8_LAS __attribute__((address_space(3)))
constexpr int BM = 256, BK = 64, HALF = 128, HTB = HALF * BK * 2, STAGE_BYTES = 8 * HTB, NXCD = 8, WGM = 8;
__host__ __device__ __forceinline__ int lds_byte(int r, int c) { const int st = (r >> 4) * 2 + (c >> 5), rr = r & 15, cc = c & 31, ob = rr * 64 + cc * 2; return st * 1024 + (ob ^ (((ob >> 9) & 1) << 5)); }
__host__ __device__ __forceinline__ void stage_rc(int b, int& R, int& C) { const int st = b / 1024, sb = b % 1024, swz = sb ^ (((sb >> 9) & 1) << 5); R = (st >> 1) * 16 + swz / 64; C = (st & 1) * 32 + (swz % 64) / 2; }
__host__ __device__ __forceinline__ int perm32(int rho) { const int n = rho >> 4, i = rho & 15; return 8 * (i >> 2) + 4 * n + (i & 3); }
struct Unit { int pm, pn; };
struct Gemm { const bf16_t* A; const bf16_t* Bt; int M, N, K; };
struct StaticOrder {
    int nM, nN, nwg, G, c;
    __host__ __device__ void init(int M, int N, int G_, int c_) { nM = M / BM; nN = N / BM; nwg = nM * nN; G = G_; c = c_; }
    __host__ __device__ bool next(int i, Unit& u) const {
        const long L = (long)i * G + c; if (L >= nwg) return false;
        int wgid = (int)L; { const int q = nwg / NXCD, r = nwg % NXCD, xcd = wgid % NXCD, off = wgid / NXCD; wgid = (xcd < r ? xcd * (q + 1) : r * (q + 1) + (xcd - r) * q) + off; }
        const int nig = WGM * nN, gid = wgid / nig, fm = gid * WGM, gsz = (nM - fm) < WGM ? (nM - fm) : WGM;
        u.pm = fm + ((wgid % nig) % gsz); u.pn = (wgid % nig) / gsz; return true;
    }
    __device__ __forceinline__ void a_ready(const Unit&) const {}
    __device__ __forceinline__ void done(const Unit&) const {}
};

template <class Epi, class Sched, bool ALIGN_EPI = false, bool SP2 = false>
__device__ __forceinline__ void gemm_phase(PG8_LAS unsigned char* lds, const Gemm g, const Sched& S, const Epi& E) {
    int tid_ = threadIdx.x; asm volatile("" : "+v"(tid_));
    const int tid = tid_, wid = __builtin_amdgcn_readfirstlane(tid >> 6), lane = tid & 63, wr = wid >> 2, wc = wid & 3, fr = lane & 15, fq = lane >> 4;
    const int K = g.K, nt = K / BK;
    unsigned voffA[2], voffB[2];
#pragma unroll
    for (int i = 0; i < 2; ++i) { int R, C; stage_rc(tid * 16 + i * 8192, R, C); const int Rb = Epi::PERM ? ((R & ~31) + perm32(R & 31)) : R;
        voffA[i] = (unsigned)(R * K + C) * 2u; voffB[i] = (unsigned)(Rb * K + C) * 2u; }
    const size_t kstep = (size_t)(BK * 2);
    const size_t hstep = (size_t)HALF * K * 2;
    const size_t tstep = 2 * hstep;
    const unsigned ldsw = (unsigned)wid * 1024u;
    const int aoff = lds_byte(wr * 64 + fr, fq * 8), boff = lds_byte(wc * 32 + fr, fq * 8);
#define PG8_SA(b, h) (((b) * 2 + (h)) * HTB)
#define PG8_SB(b, h) ((4 + (b) * 2 + (h)) * HTB)
#define PG8_STAGE(bufoff, gbase, voff) do { _Pragma("unroll") for (int _i = 0; _i < 2; ++_i) \
        __builtin_amdgcn_global_load_lds((const unsigned*)((const char*)(gbase) + (voff)[_i]), (PG8_LAS unsigned*)(lds + (bufoff) + ldsw + _i * 8192), 16, 0, 0); } while (0)
#define PG8_LDA(dst, b, h) do { _Pragma("unroll") for (int m = 0; m < 4; ++m) _Pragma("unroll") for (int k = 0; k < 2; ++k) dst[m][k] = *(const PG8_LAS bf16x8*)(lds + PG8_SA(b, h) + aoff + m * 2048 + k * 1024); } while (0)
#define PG8_LDB(dst, b, h) do { _Pragma("unroll") for (int n = 0; n < 2; ++n) _Pragma("unroll") for (int k = 0; k < 2; ++k) dst[n][k] = *(const PG8_LAS bf16x8*)(lds + PG8_SB(b, h) + boff + n * 2048 + k * 1024); } while (0)
#define PG8_MMA(ai, bj, At, Bt) do { __builtin_amdgcn_s_setprio(1); _Pragma("unroll") for (int m = 0; m < 4; ++m) _Pragma("unroll") for (int n = 0; n < 2; ++n) _Pragma("unroll") for (int k = 0; k < 2; ++k) \
        acc[ai][bj][m][n] = __builtin_amdgcn_mfma_f32_16x16x32_bf16(Bt[n][k], At[m][k], acc[ai][bj][m][n], 0, 0, 0); __builtin_amdgcn_s_setprio(0); } while (0)
#define PG8_WAIT_V(n) asm volatile("s_waitcnt vmcnt(" #n ")" ::: "memory")
#define PG8_WAIT_L(n) asm volatile("s_waitcnt lgkmcnt(" #n ")" ::: "memory")
#define PG8_BAR __builtin_amdgcn_s_barrier()
#define PG8_SCHED __builtin_amdgcn_sched_barrier(0)
    Unit cur, nxt; int ui = 0;
    if (!S.next(0, cur)) return;
    f32x4 acc[2][2][4][2];
#pragma unroll
    for (int a = 0; a < 2; ++a)
#pragma unroll
        for (int b = 0; b < 2; ++b)
#pragma unroll
            for (int m = 0; m < 4; ++m)
#pragma unroll
                for (int n = 0; n < 2; ++n) acc[a][b][m][n] = (f32x4){0.f, 0.f, 0.f, 0.f};
    bf16x8 At[4][2], B0[2][2], B1[2][2];
    const char* cA = (const char*)g.A + (size_t)cur.pm * tstep; const char* cB = (const char*)g.Bt + (size_t)cur.pn * tstep;
    S.a_ready(cur);
    if constexpr (SP2) {
        PG8_STAGE(PG8_SB(0, 0), cB, voffB); PG8_STAGE(PG8_SB(0, 1), cB + hstep, voffB); PG8_STAGE(PG8_SA(0, 0), cA, voffA); PG8_STAGE(PG8_SA(0, 1), cA + hstep, voffA);
        if (wr == 1) PG8_BAR;
        PG8_WAIT_V(2); PG8_BAR;
        PG8_STAGE(PG8_SB(1, 0), cB + kstep, voffB); PG8_STAGE(PG8_SA(1, 0), cA + kstep, voffA); PG8_STAGE(PG8_SB(1, 1), cB + hstep + kstep, voffB);
        PG8_WAIT_V(6); PG8_BAR;
    } else {
        PG8_STAGE(PG8_SB(0, 0), cB, voffB); PG8_STAGE(PG8_SA(0, 0), cA, voffA); PG8_STAGE(PG8_SB(0, 1), cB + hstep, voffB); PG8_STAGE(PG8_SA(0, 1), cA + hstep, voffA);
        if (wr == 1) PG8_BAR;
        PG8_WAIT_V(4); PG8_BAR;
        PG8_STAGE(PG8_SB(1, 0), cB + kstep, voffB); PG8_STAGE(PG8_SA(1, 0), cA + kstep, voffA); PG8_STAGE(PG8_SB(1, 1), cB + hstep + kstep, voffB);
        PG8_WAIT_V(6); PG8_BAR;
    }
    for (;;) {
        const bool has_next = S.next(ui + 1, nxt);
        const char* nA = has_next ? (const char*)g.A + (size_t)nxt.pm * tstep : cA; const char* nB = has_next ? (const char*)g.Bt + (size_t)nxt.pn * tstep : cB;
        for (int t = 0; t < nt; t += 2) {
            const bool last = (t == nt - 2);
            const char* a1 = cA + (size_t)(t + 1) * kstep;
            const char* a2 = last ? nA : cA + (size_t)(t + 2) * kstep; const char* b2 = last ? nB : cB + (size_t)(t + 2) * kstep;
            const char* a3 = a2 + kstep; const char* b3 = b2 + kstep;
            if (last && has_next) S.a_ready(nxt);
            if constexpr (SP2) {
            PG8_LDB(B0, 0, 0); PG8_LDB(B1, 0, 1); PG8_SCHED; PG8_LDA(At, 0, 0); PG8_STAGE(PG8_SA(1, 1), a1 + hstep, voffA);
            PG8_WAIT_V(8); PG8_WAIT_L(0); PG8_BAR; PG8_MMA(0, 0, At, B0); PG8_MMA(0, 1, At, B1); PG8_BAR; PG8_SCHED;
            PG8_LDA(At, 0, 1); PG8_STAGE(PG8_SB(0, 0), b2, voffB); PG8_STAGE(PG8_SB(0, 1), b2 + hstep, voffB); PG8_STAGE(PG8_SA(0, 0), a2, voffA);
            PG8_WAIT_V(8); PG8_WAIT_L(0); PG8_BAR; PG8_MMA(1, 0, At, B0); PG8_MMA(1, 1, At, B1); PG8_BAR; PG8_SCHED;
            PG8_LDB(B0, 1, 0); PG8_LDB(B1, 1, 1); PG8_SCHED; PG8_LDA(At, 1, 0); PG8_STAGE(PG8_SA(0, 1), a2 + hstep, voffA);
            PG8_WAIT_V(8); PG8_WAIT_L(0); PG8_BAR; PG8_MMA(0, 0, At, B0); PG8_MMA(0, 1, At, B1); PG8_BAR; PG8_SCHED;
            PG8_LDA(At, 1, 1); PG8_STAGE(PG8_SB(1, 0), b3, voffB); PG8_STAGE(PG8_SB(1, 1), b3 + hstep, voffB); PG8_STAGE(PG8_SA(1, 0), a3, voffA);
            PG8_WAIT_V(8); PG8_WAIT_L(0); PG8_BAR; PG8_MMA(1, 0, At, B0); PG8_MMA(1, 1, At, B1); PG8_BAR; PG8_SCHED;
            } else {
            PG8_LDB(B0, 0, 0); PG8_SCHED; PG8_LDA(At, 0, 0); PG8_STAGE(PG8_SA(1, 1), a1 + hstep, voffA);
            PG8_WAIT_L(8); PG8_BAR; PG8_WAIT_L(0); PG8_MMA(0, 0, At, B0); PG8_BAR; PG8_SCHED;
            PG8_LDB(B1, 0, 1); PG8_STAGE(PG8_SB(0, 0), b2, voffB);
            PG8_BAR; PG8_WAIT_L(0); PG8_MMA(0, 1, At, B1); PG8_BAR;
            PG8_LDA(At, 0, 1); PG8_STAGE(PG8_SA(0, 0), a2, voffA);
            PG8_BAR; PG8_WAIT_L(0); PG8_MMA(1, 0, At, B0); PG8_BAR; PG8_SCHED;
            PG8_STAGE(PG8_SB(0, 1), b2 + hstep, voffB);
            PG8_WAIT_V(6); PG8_BAR; PG8_MMA(1, 1, At, B1); PG8_BAR;
            PG8_LDB(B0, 1, 0); PG8_SCHED; PG8_LDA(At, 1, 0); PG8_STAGE(PG8_SA(0, 1), a2 + hstep, voffA);
            PG8_WAIT_L(8); PG8_BAR; PG8_WAIT_L(0); PG8_MMA(0, 0, At, B0); PG8_BAR; PG8_SCHED;
            PG8_LDB(B1, 1, 1); PG8_STAGE(PG8_SB(1, 0), b3, voffB);
            PG8_BAR; PG8_WAIT_L(0); PG8_MMA(0, 1, At, B1); PG8_BAR;
            PG8_LDA(At, 1, 1); PG8_STAGE(PG8_SA(1, 0), a3, voffA);
            PG8_BAR; PG8_WAIT_L(0); PG8_MMA(1, 0, At, B0); PG8_BAR; PG8_SCHED;
            PG8_STAGE(PG8_SB(1, 1), b3 + hstep, voffB);
            PG8_WAIT_V(6); PG8_BAR; PG8_MMA(1, 1, At, B1); PG8_BAR;
            }
        }
        if constexpr (ALIGN_EPI) { if (wr == 0) PG8_BAR; }
        if constexpr (!Epi::AFTER_DRAIN) { E(acc, cur, wr, wc, fr, fq); S.done(cur); }
        if (!has_next) break;
#pragma unroll
        for (int a = 0; a < 2; ++a)
#pragma unroll
            for (int b = 0; b < 2; ++b)
#pragma unroll
                for (int m = 0; m < 4; ++m)
#pragma unroll
                    for (int n = 0; n < 2; ++n) acc[a][b][m][n] = (f32x4){0.f, 0.f, 0.f, 0.f};
        cur = nxt; cA = nA; cB = nB; ++ui;
        if constexpr (ALIGN_EPI) { if (wr == 1) PG8_BAR; }
    }
    PG8_WAIT_V(0);
    if constexpr (!ALIGN_EPI) { if (wr == 0) PG8_BAR; }
    PG8_BAR;
#undef PG8_SA
#undef PG8_SB
#undef PG8_STAGE
#undef PG8_LDA
#undef PG8_LDB
#undef PG8_MMA
#undef PG8_WAIT_V
#undef PG8_WAIT_L
#undef PG8_BAR
#undef PG8_SCHED
}
}

__device__ __forceinline__ float rstd16(const float* ssq, int row) {
    const f32x4* p = (const f32x4*)(ssq + (size_t)row * 16); const f32x4 a = p[0], b = p[1], c = p[2], d = p[3];
    const float s = ((a[0] + a[1]) + (a[2] + a[3])) + ((b[0] + b[1]) + (b[2] + b[3])) + ((c[0] + c[1]) + (c[2] + c[3])) + ((d[0] + d[1]) + (d[2] + d[3]));
    return rsqrtf(s * (1.0f / DM) + EPS);
}

__device__ __forceinline__ float rstd16c(const float* ssq, int row, int fq) {
    const f32x4 a = *(const f32x4*)(ssq + (size_t)row * 16 + fq * 4);
    float s = (a[0] + a[1]) + (a[2] + a[3]); s += __shfl_xor(s, 16); s += __shfl_xor(s, 32);
    return rsqrtf(s * (1.0f / DM) + EPS);
}

struct EpiIn {
    static constexpr bool PERM = true, AFTER_DRAIN = false;
    unsigned char* ws; float* out; const float* bf; int fox, j;
    __device__ __forceinline__ void operator()(const f32x4 (&acc)[2][2][4][2], const pg8::Unit& u, int wr, int wc, int fr_, int fq_) const {
        int fr = fr_, fq = fq_; asm volatile("" : "+v"(fr), "+v"(fq));
        const int pn = u.pn; const bool samp = (u.pm >= MP / 256);
        const float* ssq = (const float*)(ws + WS_SSQA);
        float kmx[2] = {0.f, 0.f};
        float rsv[2][4];
#pragma unroll
        for (int ai = 0; ai < 2; ++ai)
#pragma unroll
            for (int m = 0; m < 4; ++m) rsv[ai][m] = rstd16c(ssq, u.pm * 256 + ai * 128 + wr * 64 + m * 16 + fr, fq);
        asm volatile("" ::: "memory");
#pragma unroll
        for (int ai = 0; ai < 2; ++ai)
#pragma unroll
            for (int m = 0; m < 4; ++m) {
                const int row = u.pm * 256 + ai * 128 + wr * 64 + m * 16 + fr;
                const float rs = rsv[ai][m];
                int b, t, rl; if (!samp) { b = row >> 11; t = row & 2047; rl = row; } else { rl = row - MP; b = rl >> 6; t = rl & 63; }
                float kn2[2] = {0.f, 0.f};
#pragma unroll
                for (int bj = 0; bj < 2; ++bj) {
                    const int c = bj * 128 + wc * 32 + fq * 8;
                    f32x4 v0 = acc[ai][bj][m][0] * rs, v1 = acc[ai][bj][m][1] * rs;
                    if (pn < 3) {
                        const int cg_ = pn * 256 + c, h = cg_ >> 6, d = cg_ & 63; v0 = v0 * QSCALE; v1 = v1 * QSCALE;
                        bf16_t* dst = samp ? (bf16_t*)(ws + WS_QHS) + ((size_t)(b * NH + h) * DSEQ + t) * HD + d : (bf16_t*)(ws + WS_QHP) + ((size_t)(b * NH + h) * SEQ + t) * HD + d;
                        *(u32x4*)dst = pack8(v0, v1);
                    } else if (pn == 9) {
                        const int mh = c >> 6, d = c & 63; v0 = v0 * QSCALE; v1 = v1 * QSCALE;
                        bf16_t* dst = samp ? (bf16_t*)(ws + WS_QMS) + ((size_t)(b * NMH + mh) * DSEQ + t) * HD + d : (bf16_t*)(ws + WS_QMP) + ((size_t)(b * NMH + mh) * SEQ + t) * HD + d;
                        *(u32x4*)dst = pack8(v0, v1);
                    } else if (pn < 9) {
                        const bool isv = pn >= 6;
                        const int cg_ = (pn - (isv ? 6 : 3)) * 256 + c, h = cg_ >> 6, d = cg_ & 63;
                        const size_t obase = samp ? (fox ? (isv ? O_FVS : O_FKS) : (isv ? O_SVS : O_SKS)) + (size_t)j * KVS_L : (fox ? (isv ? O_FVP : O_FKP) : (isv ? O_SVP : O_SKP)) + (size_t)j * KVP_L;
                        float* op = out + obase + (size_t)rl * MIXW + cg_;
                        *(f32x4*)op = v0; *(f32x4*)(op + 4) = v1;
                        if (!isv) kn2[bj] += ((v0[0] * v0[0] + v0[1] * v0[1]) + (v0[2] * v0[2] + v0[3] * v0[3])) + ((v1[0] * v1[0] + v1[1] * v1[1]) + (v1[2] * v1[2] + v1[3] * v1[3]));
                        if (!samp) *(u32x4*)((bf16_t*)(ws + (isv ? WS_VT : WS_KH)) + ((size_t)(b * NH + h) * SEQ + t) * HD + d) = pack8(v0, v1);
                    } else {
                        if (bj == 0 && wc == 0 && fq < 2) {
                            float* olf = out + (samp ? O_FLS + (size_t)j * MS * NH : O_FLP + (size_t)j * MP * NH);
#pragma unroll
                            for (int n = 0; n < 2; ++n) if (fq == 0 || n == 0) {
#pragma unroll
                                for (int jj = 0; jj < 4; ++jj) { const int hh = fq * 8 + n * 4 + jj; const float x = (n == 0 ? v0[jj] : v1[jj]) + bf[hh];
                                    const float lf = fminf(x, 0.f) - log1pf(expf(-fabsf(x)));
                                    olf[(size_t)rl * NH + hh] = lf; }
                            }
                        }
                    }
                }
                if (fox && !samp && pn >= 3 && pn < 6) {
#pragma unroll
                    for (int bj = 0; bj < 2; ++bj) { float q2 = kn2[bj]; q2 += __shfl_xor(q2, 16); q2 += __shfl_xor(q2, 32); kmx[bj] = fmaxf(kmx[bj], q2); }
                }
            }
        if (fox && !samp && pn >= 3 && pn < 6) {
            const int b = (u.pm * 256) >> 11;
#pragma unroll
            for (int bj = 0; bj < 2; ++bj) { float mx = kmx[bj]; mx = fmaxf(mx, __shfl_xor(mx, 1)); mx = fmaxf(mx, __shfl_xor(mx, 2)); mx = fmaxf(mx, __shfl_xor(mx, 4)); mx = fmaxf(mx, __shfl_xor(mx, 8));
                const int head = (pn - 3) * 4 + bj * 2 + (wc >> 1);
                if (fr == 0 && fq == 0) atomicMax((unsigned*)(ws + WS_KNMAX) + ((size_t)(j * NB + b) * NH + head) * 2 + (wc & 1), __float_as_uint(mx)); }
        }
    }
};

struct EpiMKV {
    static constexpr bool PERM = true, AFTER_DRAIN = false;
    unsigned char* ws; float* out; int layer0;
    __device__ __forceinline__ void operator()(const f32x4 (&acc)[2][2][4][2], const pg8::Unit& u, int wr, int wc, int fr_, int fq_) const {
        int fr = fr_, fq = fq_; asm volatile("" : "+v"(fr), "+v"(fq));
        const int layer = layer0 + (u.pn >> 1); const bool isv = (u.pn & 1);
        const float* rstdm = (const float*)(ws + WS_RSTDM);
        float rsv[2][4];
#pragma unroll
        for (int ai = 0; ai < 2; ++ai)
#pragma unroll
            for (int m = 0; m < 4; ++m) rsv[ai][m] = rstdm[u.pm * 256 + ai * 128 + wr * 64 + m * 16 + fr];
        asm volatile("" ::: "memory");
#pragma unroll
        for (int ai = 0; ai < 2; ++ai)
#pragma unroll
            for (int m = 0; m < 4; ++m) {
                const int row = u.pm * 256 + ai * 128 + wr * 64 + m * 16 + fr; const int b = row >> 8, mm = row & 255;
                const float rs = rsv[ai][m];
#pragma unroll
                for (int bj = 0; bj < 2; ++bj) {
                    const int c = bj * 128 + wc * 32 + fq * 8; const int mh = c >> 6, d = c & 63;
                    const f32x4 v0 = acc[ai][bj][m][0] * rs, v1 = acc[ai][bj][m][1] * rs;
                    float* op = out + (isv ? O_MVP : O_MKP) + ((size_t)layer * (NB * NMEM) + row) * 256 + c;
                    *(f32x4*)op = v0; *(f32x4*)(op + 4) = v1;
                    *(u32x4*)((bf16_t*)(ws + (isv ? WS_MVT : WS_MKB)) + ((size_t)((layer * NB + b) * NMH + mh) * NMEM + mm) * HD + d) = pack8(v0, v1);
                }
            }
    }
};

__device__ __forceinline__ f32x4 unpack4(u32x2 w) { return (f32x4){__uint_as_float(w.x << 16), __uint_as_float(w.x & 0xffff0000u), __uint_as_float(w.y << 16), __uint_as_float(w.y & 0xffff0000u)}; }
struct EpiRes {
    static constexpr bool PERM = true, AFTER_DRAIN = false;
    unsigned char* ws; size_t ssq_off, xb_off;
    __device__ __forceinline__ void operator()(f32x4 (&acc)[2][2][4][2], const pg8::Unit& u, int wr, int wc, int fr_, int fq_) const {
        int fr = fr_, fq = fq_; asm volatile("" : "+v"(fr), "+v"(fq));
        const bf16_t* src = (const bf16_t*)(ws + WS_XB); bf16_t* xb = (bf16_t*)(ws + xb_off); float* ssq_out = (float*)(ws + ssq_off);
        const unsigned off0 = (unsigned)((u.pm * 256 + wr * 64 + fr) * DM + u.pn * 256 + wc * 32 + fq * 8);
        u32x4 r[2][4][2];
#pragma unroll
        for (int ai = 0; ai < 2; ++ai)
#pragma unroll
            for (int m = 0; m < 4; ++m)
#pragma unroll
                for (int bj = 0; bj < 2; ++bj) r[ai][m][bj] = *(const u32x4*)(src + off0 + (unsigned)((ai * 128 + m * 16) * DM + bj * 128));
#pragma unroll
        for (int ai = 0; ai < 2; ++ai)
#pragma unroll
            for (int m = 0; m < 4; ++m)
#pragma unroll
                for (int bj = 0; bj < 2; ++bj) { const u32x4 w = r[ai][m][bj]; acc[ai][bj][m][0] += unpack4((u32x2){w.x, w.y}); acc[ai][bj][m][1] += unpack4((u32x2){w.z, w.w}); }
        asm volatile("" ::: "memory");
#pragma unroll
        for (int ai = 0; ai < 2; ++ai)
#pragma unroll
            for (int m = 0; m < 4; ++m) {
                const int row = u.pm * 256 + ai * 128 + wr * 64 + m * 16 + fr;
                float ss = 0.f;
#pragma unroll
                for (int bj = 0; bj < 2; ++bj) {
                    const f32x4 v0 = acc[ai][bj][m][0], v1 = acc[ai][bj][m][1];
                    *(u32x4*)(xb + off0 + (unsigned)((ai * 128 + m * 16) * DM + bj * 128)) = pack8(v0, v1);
                    ss += ((v0[0] * v0[0] + v0[1] * v0[1]) + (v0[2] * v0[2] + v0[3] * v0[3])) + ((v1[0] * v1[0] + v1[1] * v1[1]) + (v1[2] * v1[2] + v1[3] * v1[3]));
                }
                ss += __shfl_xor(ss, 16); ss += __shfl_xor(ss, 32);
                if (fq == 0) ssq_out[(size_t)row * 16 + u.pn * 4 + wc] = ss;
            }
    }
};

struct EpiGU {
    static constexpr bool PERM = true, AFTER_DRAIN = false;
    unsigned char* ws;
    __device__ __forceinline__ void operator()(const f32x4 (&acc)[2][2][4][2], const pg8::Unit& u, int wr, int wc, int fr_, int fq_) const {
        int fr = fr_, fq = fq_; asm volatile("" : "+v"(fr), "+v"(fq));
        const float* ssq = (const float*)(ws + WS_SSQB); bf16_t* act = (bf16_t*)(ws + WS_ACT);
        float rsv[2][4];
#pragma unroll
        for (int ai = 0; ai < 2; ++ai)
#pragma unroll
            for (int m = 0; m < 4; ++m) rsv[ai][m] = rstd16c(ssq, u.pm * 256 + ai * 128 + wr * 64 + m * 16 + fr, fq);
        asm volatile("" ::: "memory");
#pragma unroll
        for (int ai = 0; ai < 2; ++ai)
#pragma unroll
            for (int m = 0; m < 4; ++m) {
                const int row = u.pm * 256 + ai * 128 + wr * 64 + m * 16 + fr;
                const float rs = rsv[ai][m];
                f32x4 a2[2];
#pragma unroll
                for (int n = 0; n < 2; ++n) {
                    const f32x4 g = acc[ai][0][m][n] * rs, up = acc[ai][1][m][n] * rs;
#pragma unroll
                    for (int j = 0; j < 4; ++j) a2[n][j] = g[j] * __builtin_amdgcn_rcpf(1.f + __expf(-g[j])) * up[j];
                }
                *(u32x4*)(act + (size_t)row * DFF + u.pn * 128 + wc * 32 + fq * 8) = pack8(a2[0], a2[1]);
            }
    }
};

__device__ __forceinline__ float wave_sum(float v) {
#pragma unroll
    for (int o = 1; o < 64; o <<= 1) v += __shfl_xor(v, o);
    return v;
}
__device__ __forceinline__ void tr_item(const float* src, int ldw, const float* g, bf16_t* dst, int ldk, int nvalid, LAS float* scr, int lane) {
    const int nn = lane & 31;
    float tv[32];
#pragma unroll
    for (int i = 0; i < 32; ++i) { const int kk = 2 * i + (lane >> 5); tv[i] = (nn < nvalid) ? src[(size_t)kk * ldw + nn] : 0.f; }
#pragma unroll
    for (int i = 0; i < 32; ++i) { const int kk = 2 * i + (lane >> 5); float v = tv[i]; if (g) v *= g[kk]; scr[kk * 33 + nn] = v; }
    asm volatile("s_waitcnt lgkmcnt(0)" ::: "memory");
    const int c = lane & 7;
#pragma unroll
    for (int j = 0; j < 4; ++j) { const int n = (lane >> 3) + 8 * j; const LAS float* s = scr + (8 * c) * 33 + n;
        u32x4 o; o.x = cvt_pk_bf16(s[0 * 33], s[1 * 33]); o.y = cvt_pk_bf16(s[2 * 33], s[3 * 33]); o.z = cvt_pk_bf16(s[4 * 33], s[5 * 33]); o.w = cvt_pk_bf16(s[6 * 33], s[7 * 33]);
        *(u32x4*)(dst + (size_t)n * ldk + 8 * c) = o; }
    asm volatile("s_waitcnt lgkmcnt(0)" ::: "memory");
}

__device__ __forceinline__ void small_res_gemm(LAS unsigned char* lds, const bf16_t* A, const bf16_t* Bt, int K, bf16_t* xb, float* ssq, int tile) {
    int tid_ = threadIdx.x; asm volatile("" : "+v"(tid_));
    const int tid = tid_, lane = tid & 63, wid = tid >> 6, fr = lane & 15, fq = lane >> 4;
    const int rt = tile >> 3, ct = tile & 7, row0 = rt * 16, colb = ct * 128;
    const int ksl = K >> 3, nsteps = ksl >> 5;
    const bf16_t* ap = A + (size_t)(row0 + fr) * K + wid * ksl + fq * 8; const bf16_t* bp = Bt + (size_t)(colb + fr) * K + wid * ksl + fq * 8;
    f32x4 acc[8];
#pragma unroll
    for (int n = 0; n < 8; ++n) acc[n] = (f32x4){0.f, 0.f, 0.f, 0.f};
    for (int s0 = 0; s0 < nsteps; s0 += 4) {
        bf16x8 a[4], b[4][8];
#pragma unroll
        for (int i = 0; i < 4; ++i) if (s0 + i < nsteps) { a[i] = *(const bf16x8*)(ap + (s0 + i) * 32);
#pragma unroll
            for (int n = 0; n < 8; ++n) b[i][n] = *(const bf16x8*)(bp + (size_t)n * 16 * K + (s0 + i) * 32); }
#pragma unroll
        for (int i = 0; i < 4; ++i) if (s0 + i < nsteps) {
#pragma unroll
            for (int n = 0; n < 8; ++n) acc[n] = __builtin_amdgcn_mfma_f32_16x16x32_bf16(a[i], b[i][n], acc[n], 0, 0, 0); }
    }
    LAS f32x4* part = (LAS f32x4*)lds;
    LAS float* red = (LAS float*)(lds + 65536);
#pragma unroll
    for (int n = 0; n < 8; ++n) part[(wid * 8 + n) * 64 + lane] = acc[n];
    __syncthreads();
    f32x4 tot = part[wid * 64 + lane];
#pragma unroll
    for (int w = 1; w < 8; ++w) tot += part[(w * 8 + wid) * 64 + lane];
    const int col0 = colb + wid * 16;
    float ssp[4];
#pragma unroll
    for (int j = 0; j < 4; ++j) { const size_t o = (size_t)(row0 + fq * 4 + j) * DM + col0 + fr; const float v = __uint_as_float((unsigned)xb[o] << 16) + tot[j]; xb[o] = f2bf(v); ssp[j] = v * v; }
#pragma unroll
    for (int j = 0; j < 4; ++j) { ssp[j] += __shfl_xor(ssp[j], 1); ssp[j] += __shfl_xor(ssp[j], 2); ssp[j] += __shfl_xor(ssp[j], 4); ssp[j] += __shfl_xor(ssp[j], 8); }
    if (fr == 0) {
#pragma unroll
        for (int j = 0; j < 4; ++j) red[wid * 16 + fq * 4 + j] = ssp[j];
    }
    __syncthreads();
    if (tid < 16) { float t = 0.f;
#pragma unroll
        for (int w = 0; w < 8; ++w) t += red[w * 16 + tid];
        ssq[(size_t)(row0 + tid) * 16 + ct] = t;
        if (ct == 0) { *(f32x4*)(ssq + (size_t)(row0 + tid) * 16 + 8) = (f32x4){0.f, 0.f, 0.f, 0.f}; *(f32x4*)(ssq + (size_t)(row0 + tid) * 16 + 12) = (f32x4){0.f, 0.f, 0.f, 0.f}; } }
    __syncthreads();
}

constexpr int KPITCH = 144, VPITCH = 192;
constexpr int A_KS = 0, A_VS = 2 * 64 * KPITCH, A_C2 = A_VS + 2 * 64 * VPITCH, A_SCAN = A_C2 + 2560 * 4, A_UNIT = A_SCAN + 64, A_FLAG = A_UNIT + 64, A_END = A_FLAG + 64;
constexpr float THR_SB = 32.f, THR_FOX = 40.f;
__device__ __forceinline__ int crow(int i, int h) { return (i & 3) + 8 * (i >> 2) + 4 * h; }

__device__ __forceinline__ void fox_cumsum(LAS float* c2, LAS float* scan, const float* A, int split, const float* B, int n) {
    int tid_ = threadIdx.x; asm volatile("" : "+v"(tid_));
    const int tid = tid_, lane = tid & 63, wid = tid >> 6;
    float v[5]; float s = 0.f; const int t0 = tid * 5;
#pragma unroll
    for (int e = 0; e < 5; ++e) { const int t = t0 + e; float x = 0.f; if (t < n) x = (t < split) ? A[(size_t)t * NH] : B[(size_t)(t - split) * NH]; s += x; v[e] = s; }
    float w = s;
#pragma unroll
    for (int off = 1; off < 64; off <<= 1) { const float y = __shfl_up(w, off); if (lane >= off) w += y; }
    if (lane == 63) scan[wid] = w;
    __syncthreads();
    float base = w - s;
    for (int k = 0; k < wid; ++k) base += scan[k];
#pragma unroll
    for (int e = 0; e < 5; ++e) { const int t = t0 + e; if (t < n) c2[t] = (base + v[e]) * LOG2E; }
    __syncthreads();
}

typedef short v4i16_t __attribute__((ext_vector_type(4)));
__device__ __forceinline__ s16x4 vtr(const LAS unsigned char* p) { return __builtin_bit_cast(s16x4, __builtin_amdgcn_ds_read_tr16_b64_v4i16((LAS v4i16_t*)p)); }
template <bool SB>
__device__ __forceinline__ void att_tile(const LAS unsigned char* ks, const LAS unsigned char* vs, int kt, const LAS float* c2, int h, int r, const bf16x8 (&qf)[4], bool needmask, int qpos,
                                         float& mrun, float& lrun, float& Rc, f32x16& o0, f32x16& o1) {
            const int kv0 = 64 * kt;
            f32x16 p0, p1;
            if (!SB && c2) {
#pragma unroll
                for (int g = 0; g < 4; ++g) { const f32x4 ca = *(const LAS f32x4*)(c2 + kv0 + 8 * g + 4 * h), cb = *(const LAS f32x4*)(c2 + kv0 + 32 + 8 * g + 4 * h);
#pragma unroll
                    for (int e = 0; e < 4; ++e) { p0[4 * g + e] = -ca[e]; p1[4 * g + e] = -cb[e]; } }
            } else {
#pragma unroll
                for (int i = 0; i < 16; ++i) { p0[i] = 0.f; p1[i] = 0.f; }
            }
#pragma unroll
            for (int s = 0; s < 4; ++s) {
                const bf16x8 a0 = *(const LAS bf16x8*)(ks + r * KPITCH + 32 * s + 16 * h);
                const bf16x8 a1 = *(const LAS bf16x8*)(ks + (32 + r) * KPITCH + 32 * s + 16 * h);
                p0 = __builtin_amdgcn_mfma_f32_32x32x16_bf16(a0, qf[s], p0, 0, 0, 0);
                p1 = __builtin_amdgcn_mfma_f32_32x32x16_bf16(a1, qf[s], p1, 0, 0, 0);
            }
            if constexpr (!SB) {
                if (needmask) {
#pragma unroll
                    for (int i = 0; i < 16; ++i) { const int kv = kv0 + crow(i, h); if (kv > qpos) p0[i] = -1e30f; if (kv + 32 > qpos) p1[i] = -1e30f; }
                }
                float tm = fmaxf(p0[0], p1[0]);
#pragma unroll
                for (int i = 1; i < 16; ++i) tm = fmaxf(tm, fmaxf(p0[i], p1[i]));
                tm = fmaxf(tm, __shfl_xor(tm, 32));
                const float mnew = fmaxf(mrun, tm);
                {
                    const float alpha = __builtin_amdgcn_exp2f(mrun - mnew); mrun = mnew; lrun *= alpha;
#pragma unroll
                    for (int i = 0; i < 16; ++i) { o0[i] *= alpha; o1[i] *= alpha; }
                }
                float rsum = 0.f;
#pragma unroll
                for (int i = 0; i < 16; ++i) { p0[i] = __builtin_amdgcn_exp2f(p0[i] - mrun); p1[i] = __builtin_amdgcn_exp2f(p1[i] - mrun); rsum += p0[i] + p1[i]; }
                lrun += rsum;
            } else {
                f32x16 B0, B1;
#pragma unroll
                for (int i = 0; i < 16; ++i) {
                    const float e0 = __builtin_amdgcn_exp2f(fminf(p0[i], 80.f)), e1 = __builtin_amdgcn_exp2f(fminf(p1[i], 80.f));
                    float m0 = __builtin_amdgcn_rcpf(1.f + e0), m1 = __builtin_amdgcn_rcpf(1.f + e1);
                    float b0 = e0 * m0, b1 = e1 * m1;
                    if (needmask) { const int kv = kv0 + crow(i, h); if (kv >= qpos) { m0 = 1.f; b0 = 0.f; } if (kv + 32 >= qpos) { m1 = 1.f; b1 = 0.f; } }
                    p0[i] = m0; p1[i] = m1; B0[i] = b0; B1[i] = b1;
                }
                float T[8], To[8];
#pragma unroll
                for (int g = 0; g < 4; ++g) { T[g] = (p0[4 * g] * p0[4 * g + 1]) * (p0[4 * g + 2] * p0[4 * g + 3]); T[4 + g] = (p1[4 * g] * p1[4 * g + 1]) * (p1[4 * g + 2] * p1[4 * g + 3]); }
#pragma unroll
                for (int k = 0; k < 8; ++k) To[k] = __shfl_xor(T[k], 32);
                float rc = Rc;
#pragma unroll
                for (int k = 7; k >= 0; --k) {
                    const float w3 = rc * (h == 0 ? To[k] : 1.f);
                    const int g = k & 3;
                    if (k >= 4) { const float w2 = w3 * p1[4 * g + 3], w1 = w2 * p1[4 * g + 2], w0 = w1 * p1[4 * g + 1];
                        p1[4 * g + 3] = B1[4 * g + 3] * w3; p1[4 * g + 2] = B1[4 * g + 2] * w2; p1[4 * g + 1] = B1[4 * g + 1] * w1; p1[4 * g] = B1[4 * g] * w0; }
                    else { const float w2 = w3 * p0[4 * g + 3], w1 = w2 * p0[4 * g + 2], w0 = w1 * p0[4 * g + 1];
                        p0[4 * g + 3] = B0[4 * g + 3] * w3; p0[4 * g + 2] = B0[4 * g + 2] * w2; p0[4 * g + 1] = B0[4 * g + 1] * w1; p0[4 * g] = B0[4 * g] * w0; }
                    rc *= T[k] * To[k];
                }
                Rc = rc;
            }
            bf16x8 pf[4];
            { u32x4 w;
              w.x = cvt_pk_bf16(p0[0], p0[1]); w.y = cvt_pk_bf16(p0[2], p0[3]); w.z = cvt_pk_bf16(p0[4], p0[5]); w.w = cvt_pk_bf16(p0[6], p0[7]); pf[0] = __builtin_bit_cast(bf16x8, w);
              w.x = cvt_pk_bf16(p0[8], p0[9]); w.y = cvt_pk_bf16(p0[10], p0[11]); w.z = cvt_pk_bf16(p0[12], p0[13]); w.w = cvt_pk_bf16(p0[14], p0[15]); pf[1] = __builtin_bit_cast(bf16x8, w);
              w.x = cvt_pk_bf16(p1[0], p1[1]); w.y = cvt_pk_bf16(p1[2], p1[3]); w.z = cvt_pk_bf16(p1[4], p1[5]); w.w = cvt_pk_bf16(p1[6], p1[7]); pf[2] = __builtin_bit_cast(bf16x8, w);
              w.x = cvt_pk_bf16(p1[8], p1[9]); w.y = cvt_pk_bf16(p1[10], p1[11]); w.z = cvt_pk_bf16(p1[12], p1[13]); w.w = cvt_pk_bf16(p1[14], p1[15]); pf[3] = __builtin_bit_cast(bf16x8, w); }
            const LAS unsigned char* vtb = vs + (4 * h + ((r & 15) >> 2)) * VPITCH + (r >> 4) * 32 + (r & 3) * 8;
#pragma unroll
            for (int ps = 0; ps < 4; ++ps) {
                const s16x4 lo0 = vtr(vtb + (16 * ps) * VPITCH), hi0 = vtr(vtb + (16 * ps + 8) * VPITCH);
                const s16x4 lo1 = vtr(vtb + (16 * ps) * VPITCH + 64), hi1 = vtr(vtb + (16 * ps + 8) * VPITCH + 64);
                const bf16x8 va0 = (bf16x8){lo0[0], lo0[1], lo0[2], lo0[3], hi0[0], hi0[1], hi0[2], hi0[3]};
                const bf16x8 va1 = (bf16x8){lo1[0], lo1[1], lo1[2], lo1[3], hi1[0], hi1[1], hi1[2], hi1[3]};
                o0 = __builtin_amdgcn_mfma_f32_32x32x16_bf16(va0, pf[ps], o0, 0, 0, 0);
                o1 = __builtin_amdgcn_mfma_f32_32x32x16_bf16(va1, pf[ps], o1, 0, 0, 0);
            }
}

template <bool SB, bool F32>
__device__ __forceinline__ void attn_unit(LAS unsigned char* lds, const bf16_t* Q, int nq, int qpos0, const void* K1, const void* V1, int ld1,
                                          const float* K2, const float* V2, int ksplit, int ntile, bool causal, const LAS float* c2, bf16_t* O, float kmax,
                                          const float* csA = nullptr, int cs_split = 0, const float* csB = nullptr, int cs_n = 0) {
    int tid_ = threadIdx.x; asm volatile("" : "+v"(tid_));
    const int tid = tid_, lane = tid & 63, wid = __builtin_amdgcn_readfirstlane(tid >> 6), r = lane & 31, h = lane >> 5;
    const bool active = (wid * 32 < nq);
    bf16x8 qf[4];
#pragma unroll
    for (int s = 0; s < 4; ++s) qf[s] = active ? *(const bf16x8*)(Q + (size_t)(wid * 32 + r) * HD + 16 * s + 8 * h) : (bf16x8){0, 0, 0, 0, 0, 0, 0, 0};
    const int qmin = qpos0 + wid * 32, qmax = qmin + 31, qpos = qmin + r;
    const bool prune = SB || (kmax > 0.f);
    float qn = 0.f;
    if (!SB && prune) {
#pragma unroll
        for (int s_ = 0; s_ < 4; ++s_)
#pragma unroll
            for (int e = 0; e < 8; ++e) { const float f = __uint_as_float(((unsigned)(unsigned short)qf[s_][e]) << 16); qn += f * f; }
        qn += __shfl_xor(qn, 32); qn = sqrtf(qn) * kmax;
    }
    volatile LAS int* flags = (volatile LAS int*)(lds + A_FLAG);
    f32x16 o0, o1;
#pragma unroll
    for (int i = 0; i < 16; ++i) { o0[i] = 0.f; o1[i] = 0.f; }
    float mrun = -1e30f, lrun = 0.f, Rc = 1.f;
    u32x4 krA, vrA, krB, vrB; f32x4 kfA[2], vfA[2], kfB[2], vfB[2];
    const int srow = tid >> 3, sch = tid & 7;
#define ATT_LOAD(kt, X) do { if constexpr (F32) { _Pragma("unroll") for (int i_ = 0; i_ < 2; ++i_) { const int idx_ = tid + 512 * i_, row_ = idx_ >> 4, c4_ = idx_ & 15, key_ = (kt) * 64 + row_; \
            const float* kp_ = key_ < ksplit ? (const float*)K1 + (size_t)key_ * ld1 : K2 + (size_t)(key_ - ksplit) * ld1; \
            const float* vp_ = key_ < ksplit ? (const float*)V1 + (size_t)key_ * ld1 : V2 + (size_t)(key_ - ksplit) * ld1; \
            kf##X[i_] = *(const f32x4*)(kp_ + c4_ * 4); vf##X[i_] = *(const f32x4*)(vp_ + c4_ * 4); } } \
        else { kr##X = *(const u32x4*)((const bf16_t*)K1 + ((size_t)(kt) * 64 + srow) * HD + sch * 8); vr##X = *(const u32x4*)((const bf16_t*)V1 + ((size_t)(kt) * 64 + srow) * HD + sch * 8); } } while (0)
#define ATT_STORE(buf, X) do { LAS unsigned char* ks_ = lds + A_KS + (buf) * 64 * KPITCH; LAS unsigned char* vs_ = lds + A_VS + (buf) * 64 * VPITCH; \
        if constexpr (F32) { _Pragma("unroll") for (int i_ = 0; i_ < 2; ++i_) { const int idx_ = tid + 512 * i_, row_ = idx_ >> 4, c4_ = idx_ & 15; \
            *(LAS u32x2*)(ks_ + row_ * KPITCH + c4_ * 8) = pack4(kf##X[i_]); *(LAS u32x2*)(vs_ + row_ * VPITCH + c4_ * 8) = pack4(vf##X[i_]); } } \
        else { *(LAS u32x4*)(ks_ + srow * KPITCH + sch * 16) = kr##X; *(LAS u32x4*)(vs_ + srow * VPITCH + sch * 16) = vr##X; } } while (0)
#define ATT_STEP(IT, LD, ST) { const int it_ = (IT), kt = ntile - 1 - it_, buf = it_ & 1; \
        if (prune && it_ > 0) { volatile LAS int* fl = flags + ((it_ - 1) & 1) * 8; const int all_ = fl[0] & fl[1] & fl[2] & fl[3] & fl[4] & fl[5] & fl[6] & fl[7]; if (all_) break; } \
        if (it_ + 2 < ntile) ATT_LOAD(kt - 2, LD); \
        if (active && !(causal && 64 * kt > qmax)) \
            att_tile<SB>(lds + A_KS + buf * 64 * KPITCH, lds + A_VS + buf * 64 * VPITCH, kt, c2, h, r, qf, causal && (64 * kt + 63 >= qmin), qpos, mrun, lrun, Rc, o0, o1); \
        if (prune && kt > 0) { \
            bool done = true; \
            if (active) { \
                if constexpr (SB) done = __all(Rc < 2.3283064e-10f);   \
                else { const int kn = 64 * kt - 1; done = (kn < qmin) && __all(qn - c2[kn] < mrun - THR_FOX); } \
            } \
            if (lane == 0) flags[(it_ & 1) * 8 + wid] = done ? 1 : 0; \
        } \
        if (it_ + 1 < ntile) ATT_STORE(buf ^ 1, ST); \
        __syncthreads(); }
    ATT_LOAD(ntile - 1, A);
    if (csA) fox_cumsum((LAS float*)c2, (LAS float*)(lds + A_SCAN), csA, cs_split, csB, cs_n);
    ATT_STORE(0, A);
    if (ntile > 1) ATT_LOAD(ntile - 2, A);
    __syncthreads();
    for (int it = 0; it < ntile; it += 2) {
        ATT_STEP(it, B, A)
        if (it + 1 >= ntile) break;
        ATT_STEP(it + 1, A, B)
    }
#undef ATT_STEP
#undef ATT_LOAD
#undef ATT_STORE
    if (active) {
        float inv = 1.f;
        if constexpr (!SB) { const float lt = lrun + __shfl_xor(lrun, 32); inv = 1.f / lt; }
        bf16_t* orow = O + (size_t)(wid * 32 + r) * DM;
#pragma unroll
        for (int g = 0; g < 4; ++g) {
            f32x4 a = (f32x4){o0[4 * g], o0[4 * g + 1], o0[4 * g + 2], o0[4 * g + 3]} * inv, b = (f32x4){o1[4 * g], o1[4 * g + 1], o1[4 * g + 2], o1[4 * g + 3]} * inv;
            *(u32x2*)(orow + 8 * g + 4 * h) = pack4(a); *(u32x2*)(orow + 32 + 8 * g + 4 * h) = pack4(b);
        }
    }
}

#define XB_TMO      128
#define XB_XCNT(j)  (256  + 64 * (j))
#define XB_XSUB(j)  (1280 + 64 * (j))
#define XB_XGEN(j)  (2304 + 64 * (j))
#define XB_TOP      3328
#define XB_TOPGEN   3392
#define XCD_BAR_WORDS 3456
#define XB_SPIN_CAP (1u << 18)
__device__ __forceinline__ unsigned xb_ld(unsigned* p)              { return __hip_atomic_load(p, __ATOMIC_RELAXED, __HIP_MEMORY_SCOPE_AGENT); }
__device__ __forceinline__ unsigned xb_add(unsigned* p, unsigned v) { return __hip_atomic_fetch_add(p, v, __ATOMIC_RELAXED, __HIP_MEMORY_SCOPE_AGENT); }
__device__ __forceinline__ unsigned xb_xcc_id() { return (unsigned)__builtin_amdgcn_s_getreg((3 << 11) | 20) & 0xFu; }
#define XB_SPIN(cond, bar) do { unsigned _sp = 0; while (cond) { __builtin_amdgcn_s_sleep(1); \
    if ((++_sp & 255u) == 0u) { if (xb_ld(&(bar)[XB_TMO])) break; if (_sp > XB_SPIN_CAP) { atomicAdd(&(bar)[XB_TMO], 1u); break; } } } } while (0)
struct XcdBarrier { unsigned* bar; unsigned x; volatile LAS unsigned* st; };
__device__ __forceinline__ XcdBarrier xcd_barrier_post(unsigned* bar, volatile LAS unsigned* st) {
    XcdBarrier b; b.bar = bar; b.x = xb_xcc_id(); b.st = st;
    if (threadIdx.x == 0) (void)xb_add(&bar[XB_XCNT(b.x)], 1u);
    return b;
}
__device__ __forceinline__ void xcd_barrier_complete(unsigned* bar, unsigned x, unsigned& nloc, unsigned& nx) {
    const unsigned G = gridDim.x * gridDim.y * gridDim.z;
    unsigned sum, cnt, mine, sp = 0u;
    for (;;) {
        sum = 0u; cnt = 0u; mine = 0u;
#pragma unroll
        for (unsigned j = 0; j < 16; ++j) { const unsigned c = xb_ld(&bar[XB_XCNT(j)]); sum += c; cnt += (c > 0u) ? 1u : 0u; mine = (j == x) ? c : mine; }
        if (sum == G) break;
        __builtin_amdgcn_s_sleep(1);
        if ((++sp & 255u) == 0u) { if (xb_ld(&bar[XB_TMO])) break; if (sp > XB_SPIN_CAP) { atomicAdd(&bar[XB_TMO], 1u); break; } }
    }
    nloc = mine > 0u ? mine : 1u; nx = cnt > 0u ? cnt : 1u;
}
__device__ __forceinline__ void xcd_barrier(const XcdBarrier& b) {
    asm volatile("s_waitcnt vmcnt(0)" ::: "memory");
    __syncthreads();
    if (threadIdx.x == 0) {
        unsigned* bar = b.bar;
        __builtin_amdgcn_s_waitcnt(0);
        unsigned nloc = b.st[0], nx = b.st[1];
        if (nloc == 0u) { xcd_barrier_complete(bar, b.x, nloc, nx); b.st[0] = nloc; b.st[1] = nx; }
        const unsigned old = xb_add(&bar[XB_XSUB(b.x)], 1u);
        const unsigned gen = old / nloc;
        if (old + 1u == (gen + 1u) * nloc) {
            __builtin_amdgcn_fence(__ATOMIC_RELEASE, "agent");
            asm volatile("s_waitcnt vmcnt(0)" ::: "memory");
            const unsigned og = xb_add(&bar[XB_TOP], 1u);
            const unsigned tg = og / nx;
            if (og + 1u == (tg + 1u) * nx) xb_add(&bar[XB_TOPGEN], 1u);
            else XB_SPIN(xb_ld(&bar[XB_TOPGEN]) == tg, bar);
            __builtin_amdgcn_fence(__ATOMIC_ACQUIRE, "agent");
            xb_add(&bar[XB_XGEN(b.x)], 1u);
            asm volatile("s_waitcnt vmcnt(0)" ::: "memory");
        } else {
            XB_SPIN(xb_ld(&bar[XB_XGEN(b.x)]) == gen, bar);
            __builtin_amdgcn_fence(__ATOMIC_ACQUIRE, "agent");
            asm volatile("s_waitcnt vmcnt(0)" ::: "memory");
        }
    }
    __syncthreads();
}

struct Params { const float* in[21]; float* out; unsigned char* ws; int ph_lo, ph_hi; };
constexpr int LDS_BYTES = pg8::STAGE_BYTES + 4096;
constexpr int N_PHASES = 22;

__global__ void __launch_bounds__(512, 2) mega(Params p) {
    extern __shared__ __attribute__((aligned(16))) unsigned char lds_raw[];
    LAS unsigned char* lds = (LAS unsigned char*)lds_raw;
    const int tid = threadIdx.x, lane = tid & 63, wave = __builtin_amdgcn_readfirstlane(tid >> 6);
    const int G = gridDim.x, bid = blockIdx.x;
    const int lo = p.ph_lo, hi = p.ph_hi;
#define IN(k) (lo <= (k) && (k) < hi)
    volatile LAS unsigned* MISC = (volatile LAS unsigned*)(lds + pg8::STAGE_BYTES);
    if (tid < 2) MISC[tid] = 0u;
    __syncthreads();
    XcdBarrier xbar; xbar.bar = (unsigned*)(p.ws + WS_BAR); xbar.x = 0; xbar.st = MISC;
    if (ONE_LAUNCH) xbar = xcd_barrier_post((unsigned*)(p.ws + WS_BAR), MISC);
#define SEAM(k) do { if (IN(k) && IN((k) + 1)) { xcd_barrier(xbar); if (DUP & 64) { xcd_barrier(xbar); xcd_barrier(xbar); } } } while (0)
    if (lo < 0) cg::this_grid().sync();
#define WSP(T, off) ((T*)(p.ws + (off)))

    if (IN(0) && !NO_P0) for (int rep0 = 0; rep0 < ((DUP & 1) ? 2 : 1); ++rep0) {
        if (bid == 0 && tid < 16) WSP(unsigned, WS_CTR)[tid] = 0u;
        LAS float* scr = (LAS float*)(lds + wave * 16384);
        const int gw = bid * 8 + wave, NGW = G * 8;
        constexpr int I_IN = 4 * 16 * 88, I_OUT = 4 * 16 * 32, I_GU = 4 * 16 * 176, I_DN = 4 * 44 * 32, I_MKV = 4 * 16 * 16;
        constexpr int NITEMS = I_IN + I_OUT + I_GU + I_DN + I_MKV;
        for (int it = gw; it < NITEMS; it += NGW) {
            int r = it;
            if (r < I_IN) {
                const int L = r / 1408; r %= 1408; const int kb = r / 88, nb = r % 88; const bool fox = !(L & 1); const int j = L >> 1;
                const float* W = fox ? p.in[11] + (size_t)j * DM * 2572 : p.in[13] + (size_t)j * DM * 2560; const int ldw = fox ? 2572 : 2560;
                const int n0 = nb * 32; int srccol, nvalid = 32;
                if (n0 < 2304) srccol = n0;
                else if (n0 < 2560) srccol = (fox ? 2316 : 2304) + (n0 - 2304);
                else { if (!fox) continue; if (nb == 80) { srccol = 2304; nvalid = 12; } else { srccol = 0; nvalid = 0; } }
                tr_item(W + (size_t)kb * 64 * ldw + srccol, ldw, p.in[10] + L * DM + kb * 64, WSP(bf16_t, WS_WIN) + (size_t)L * NIN_PAD * DM + (size_t)n0 * DM + kb * 64, DM, nvalid, scr, lane);
                continue;
            }
            r -= I_IN;
            if (r < I_OUT) {
                const int L = r / 512; r %= 512; const int kb = r / 32, nb = r % 32;
                tr_item(p.in[16] + (size_t)L * DM * DM + (size_t)kb * 64 * DM + nb * 32, DM, nullptr, WSP(bf16_t, WS_WOUT) + (size_t)L * DM * DM + (size_t)nb * 32 * DM + kb * 64, DM, 32, scr, lane);
                continue;
            }
            r -= I_OUT;
            if (r < I_GU) {
                const int L = r / 2816; r %= 2816; const int kb = r / 176, nb = r % 176; const int pn = nb >> 3, bj = (nb & 7) >> 2, cb = nb & 3;
                const int srccol = bj * DFF + pn * 128 + cb * 32;
                tr_item(p.in[18] + (size_t)L * DM * 2 * DFF + (size_t)kb * 64 * 2 * DFF + srccol, 2 * DFF, p.in[17] + L * DM + kb * 64, WSP(bf16_t, WS_WGU) + (size_t)L * 2 * DFF * DM + (size_t)nb * 32 * DM + kb * 64, DM, 32, scr, lane);
                continue;
            }
            r -= I_GU;
            if (r < I_DN) {
                const int L = r / 1408; r %= 1408; const int kb = r / 32, nb = r % 32;
                tr_item(p.in[19] + (size_t)L * DFF * DM + (size_t)kb * 64 * DM + nb * 32, DM, nullptr, WSP(bf16_t, WS_WDN) + (size_t)L * DM * DFF + (size_t)nb * 32 * DFF + kb * 64, DFF, 32, scr, lane);
                continue;
            }
            r -= I_DN;
            {
                const int L = r / 256; r %= 256; const int kb = r / 16, nb = r % 16;
                tr_item(p.in[15] + (size_t)L * DM * 512 + (size_t)kb * 64 * 512 + nb * 32, 512, p.in[14] + L * DM + kb * 64, WSP(bf16_t, WS_WMKV) + (size_t)L * 512 * DM + (size_t)nb * 32 * DM + kb * 64, DM, 32, scr, lane);
            }
        }
        for (int rowa = gw; rowa < MTOT + NB * NMEM; rowa += 2 * NGW) {
            f32x4 v[2][4]; const float* src[2]; bf16_t* dst[2]; bool ok[2], ismem[2]; int rw[2];
#pragma unroll
            for (int q = 0; q < 2; ++q) { const int row = rowa + q * NGW; rw[q] = row; ok[q] = row < MTOT + NB * NMEM; ismem[q] = row >= MTOT;
                src[q] = ismem[q] ? p.in[2] + (size_t)(row - MTOT) * DM : (row < MP ? p.in[0] + (size_t)row * DM : p.in[1] + (size_t)(row - MP) * DM);
                dst[q] = ismem[q] ? WSP(bf16_t, WS_MPB) + (size_t)(row - MTOT) * DM : WSP(bf16_t, WS_XB) + (size_t)row * DM;
#pragma unroll
                for (int j = 0; j < 4; ++j) v[q][j] = ok[q] ? *(const f32x4*)(src[q] + j * 256 + lane * 4) : (f32x4){0.f, 0.f, 0.f, 0.f}; }
#pragma unroll
            for (int q = 0; q < 2; ++q) if (ok[q]) {
                float ss = 0.f;
#pragma unroll
                for (int j = 0; j < 4; ++j) { const f32x4 w = v[q][j]; ss += (w[0] * w[0] + w[1] * w[1]) + (w[2] * w[2] + w[3] * w[3]); *(u32x2*)(dst[q] + j * 256 + lane * 4) = pack4(w); }
                ss = wave_sum(ss);
                if (ismem[q]) { if (lane == 0) WSP(float, WS_RSTDM)[rw[q] - MTOT] = rsqrtf(ss * (1.0f / DM) + EPS); }
                else if (lane < 16) WSP(float, WS_SSQA)[(size_t)rw[q] * 16 + lane] = (lane == 0) ? ss : 0.f;
            }
        }
        __syncthreads();
    }
    SEAM(0);

#pragma unroll 1
    for (int L = 0; L < 4; ++L) {
        const bool fox = !(L & 1); const int j = L >> 1; const int P0 = 1 + 5 * L;
        if (IN(P0) && !NO_PIN) {
            const int N = fox ? NIN_PAD : 2560;
            { pg8::Gemm g{WSP(bf16_t, WS_XB), WSP(bf16_t, WS_WIN) + (size_t)L * NIN_PAD * DM, MTOT, N, DM}; pg8::StaticOrder S; S.init(MTOT, N, G, bid);
              EpiIn E{p.ws, p.out, p.in[12] + j * NH, fox ? 1 : 0, j};
              if (DUP & 2) pg8::gemm_phase<EpiIn, pg8::StaticOrder, true, SP2V>(lds, g, S, E);
              pg8::gemm_phase<EpiIn, pg8::StaticOrder, true, SP2V>(lds, g, S, E); }
            if (L < 2) {
                const int nl = (L == 0) ? 1 : 3, l0 = (L == 0) ? 0 : 1; const int rot = ((MTOT / 256) * (N / 256)) % G;
                pg8::Gemm g{WSP(bf16_t, WS_MPB), WSP(bf16_t, WS_WMKV) + (size_t)l0 * 512 * DM, NB * NMEM, nl * 512, DM}; pg8::StaticOrder S; S.init(NB * NMEM, nl * 512, G, (bid + G - rot) % G);
                EpiMKV E{p.ws, p.out, l0};
                pg8::gemm_phase<EpiMKV, pg8::StaticOrder, true, SP2V>(lds, g, S, E);
            }
        }
        SEAM(P0);
        if (IN(P0 + 1) && !NO_ATT) {
            LAS float* c2 = (LAS float*)(lds + A_C2); LAS float* scan = (LAS float*)(lds + A_SCAN); volatile LAS int* su = (volatile LAS int*)(lds + A_UNIT);
            constexpr int U_S = NB * NH, U_P = NB * NH * 8, U_MP = NB * NMH * 8, U_MS = NB * NMH, U_TOT = U_S + U_P + U_MP + U_MS;
            float* out = p.out;
            float* ok_s = out + (fox ? O_FKS : O_SKS) + (size_t)j * KVS_L; float* ov_s = out + (fox ? O_FVS : O_SVS) + (size_t)j * KVS_L;
            float* olf_p = out + O_FLP + (size_t)j * MP * NH; float* olf_s = out + O_FLS + (size_t)j * MS * NH;
            bf16_t* OB = WSP(bf16_t, WS_OB);
            for (int rep = 0; rep < ((DUP & 4) ? 2 : 1); ++rep) {
            for (;;) {
                if (tid == 0) su[0] = (int)atomicAdd(WSP(unsigned, WS_CTR) + L + 4 * rep, 1u);
                __syncthreads();
                const int un = su[0];
                __syncthreads();
                if (un >= U_TOT) break;
                if (un < U_S) {
                    const int bh = un, b = bh / NH, h = bh % NH;
                    const float* K1 = (fox ? p.in[3] : p.in[6]) + (size_t)j * NB * PAST * MIXW + (size_t)b * PAST * MIXW + h * HD;
                    const float* V1 = (fox ? p.in[4] : p.in[7]) + (size_t)j * NB * PAST * MIXW + (size_t)b * PAST * MIXW + h * HD;
                    const float* K2 = ok_s + (size_t)b * DSEQ * MIXW + h * HD; const float* V2 = ov_s + (size_t)b * DSEQ * MIXW + h * HD;
                    bf16_t* O = OB + (size_t)(MP + b * DSEQ) * DM + h * HD;
                    const bf16_t* Q = WSP(bf16_t, WS_QHS) + (size_t)bh * DSEQ * HD;
                    if (fox) {
                        float n2 = 0.f;
                        { const float* kr = K2 + (size_t)(tid & 63) * MIXW;
#pragma unroll
                          for (int i = 0; i < 16; ++i) { const f32x4 v = *(const f32x4*)(kr + i * 4); n2 += (v[0] * v[0] + v[1] * v[1]) + (v[2] * v[2] + v[3] * v[3]); }
#pragma unroll
                          for (int o_ = 1; o_ < 64; o_ <<= 1) n2 = fmaxf(n2, __shfl_xor(n2, o_)); }
                        { float mx = 0.f;
#pragma unroll 1
                          for (int r0 = 0; r0 < PAST; r0 += 32 * 16) {
                              f32x4 kv[16];
#pragma unroll
                              for (int i = 0; i < 16; ++i) kv[i] = *(const f32x4*)(K1 + (size_t)(r0 + i * 32 + (tid >> 4)) * MIXW + (tid & 15) * 4);
#pragma unroll
                              for (int i = 0; i < 16; ++i) { float q2 = (kv[i][0] * kv[i][0] + kv[i][1] * kv[i][1]) + (kv[i][2] * kv[i][2] + kv[i][3] * kv[i][3]);
                                  q2 += __shfl_xor(q2, 1); q2 += __shfl_xor(q2, 2); q2 += __shfl_xor(q2, 4); q2 += __shfl_xor(q2, 8); mx = fmaxf(mx, q2); }
                          }
#pragma unroll
                          for (int o_ = 16; o_ < 64; o_ <<= 1) mx = fmaxf(mx, __shfl_xor(mx, o_));
                          if ((tid & 63) == 0) scan[tid >> 6] = mx;
                          __syncthreads();
                          float m8 = scan[0];
#pragma unroll
                          for (int w = 1; w < 8; ++w) m8 = fmaxf(m8, scan[w]);
                          __syncthreads();
                          n2 = fmaxf(n2, m8); }
                        const float kmax = sqrtf(n2) * 1.01f;
                        attn_unit<false, true>(lds, Q, DSEQ, PAST, K1, V1, MIXW, K2, V2, PAST, (PAST + DSEQ) / 64, true, c2, O, kmax,
                                               p.in[5] + (size_t)j * NB * PAST * NH + (size_t)b * PAST * NH + h, PAST, olf_s + (size_t)b * DSEQ * NH + h, PAST + DSEQ); }
                    else attn_unit<true, true>(lds, Q, DSEQ, PAST, K1, V1, MIXW, K2, V2, PAST, (PAST + DSEQ) / 64, true, nullptr, O, -1.f);
                } else if (un < U_S + U_P) {
                    const int k = un - U_S, qt = 7 - k / (NB * NH), bh = k % (NB * NH), b = bh / NH, h = bh % NH;
                    const bf16_t* Q = WSP(bf16_t, WS_QHP) + ((size_t)bh * SEQ + qt * 256) * HD; const bf16_t* K1 = WSP(bf16_t, WS_KH) + (size_t)bh * SEQ * HD; const bf16_t* V1 = WSP(bf16_t, WS_VT) + (size_t)bh * SEQ * HD;
                    bf16_t* O = OB + (size_t)(b * SEQ + qt * 256) * DM + h * HD;
                    if (fox) {
                        const unsigned* kq = WSP(unsigned, WS_KNMAX) + ((size_t)j * NB * NH + bh) * 2;
                        const float kmax = sqrtf(__uint_as_float(kq[0]) + __uint_as_float(kq[1])) * 1.01f;
                        attn_unit<false, false>(lds, Q, 256, qt * 256, K1, V1, SEQ, nullptr, nullptr, 1 << 30, 4 * (qt + 1), true, c2, O, kmax, olf_p + (size_t)b * SEQ * NH + h, 1 << 30, nullptr, 256 * (qt + 1)); }
                    else attn_unit<true, false>(lds, Q, 256, qt * 256, K1, V1, SEQ, nullptr, nullptr, 1 << 30, 4 * (qt + 1), true, nullptr, O, -1.f);
                } else if (un < U_S + U_P + U_MP) {
                    const int k = un - U_S - U_P, bm = k >> 3, qt = k & 7, b = bm >> 2, mh = bm & 3;
                    attn_unit<false, false>(lds, WSP(bf16_t, WS_QMP) + ((size_t)bm * SEQ + qt * 256) * HD, 256, 0, WSP(bf16_t, WS_MKB) + (size_t)(L * NB * NMH + bm) * NMEM * HD, WSP(bf16_t, WS_MVT) + (size_t)(L * NB * NMH + bm) * NMEM * HD, NMEM,
                                            nullptr, nullptr, 1 << 30, NMEM / 64, false, nullptr, OB + (size_t)(b * SEQ + qt * 256) * DM + MIXW + mh * HD, -1.f);
                } else {
                    const int bm = un - U_S - U_P - U_MP, b = bm >> 2, mh = bm & 3;
                    attn_unit<false, true>(lds, WSP(bf16_t, WS_QMS) + (size_t)bm * DSEQ * HD, DSEQ, 0, p.in[8] + ((size_t)(L * NB + b) * NMEM * NMH + mh) * HD, p.in[9] + ((size_t)(L * NB + b) * NMEM * NMH + mh) * HD, NMH * HD,
                                           nullptr, nullptr, 1 << 30, NMEM / 64, false, nullptr, OB + (size_t)(MP + b * DSEQ) * DM + MIXW + mh * HD, -1.f);
                }
            }
            }
        }
        SEAM(P0 + 1);
        if (IN(P0 + 2) && !NO_POUT) {
            pg8::Gemm g{WSP(bf16_t, WS_OB), WSP(bf16_t, WS_WOUT) + (size_t)L * DM * DM, MP, DM, DM}; pg8::StaticOrder S; S.init(MP, DM, G, bid);
            if (DUP & 8) { EpiRes E2{p.ws, WS_DSSQ, WS_DXB}; pg8::gemm_phase<EpiRes, pg8::StaticOrder, true, SP2V>(lds, g, S, E2); }
            EpiRes E{p.ws, WS_SSQB, WS_XB};
            pg8::gemm_phase<EpiRes, pg8::StaticOrder, true, SP2V>(lds, g, S, E);
            for (int tile = bid; tile < 256; tile += G)
                small_res_gemm(lds, WSP(bf16_t, WS_OB) + (size_t)MP * DM, WSP(bf16_t, WS_WOUT) + (size_t)L * DM * DM, DM, WSP(bf16_t, WS_XB) + (size_t)MP * DM, WSP(float, WS_SSQB) + (size_t)MP * 16, tile);
        }
        SEAM(P0 + 2);
        if (IN(P0 + 3) && !NO_PGU) {
            pg8::Gemm g{WSP(bf16_t, WS_XB), WSP(bf16_t, WS_WGU) + (size_t)L * 2 * DFF * DM, MTOT, 2 * DFF, DM}; pg8::StaticOrder S; S.init(MTOT, 2 * DFF, G, bid);
            EpiGU E{p.ws};
            if (DUP & 16) pg8::gemm_phase<EpiGU, pg8::StaticOrder, true, SP2V>(lds, g, S, E);
            pg8::gemm_phase<EpiGU, pg8::StaticOrder, true, SP2V>(lds, g, S, E);
        }
        SEAM(P0 + 3);
        if (IN(P0 + 4) && !NO_PDN) {
            pg8::Gemm g{WSP(bf16_t, WS_ACT), WSP(bf16_t, WS_WDN) + (size_t)L * DM * DFF, MP, DM, DFF}; pg8::StaticOrder S; S.init(MP, DM, G, bid);
            if (DUP & 32) { EpiRes E2{p.ws, WS_DSSQ, WS_DXB}; pg8::gemm_phase<EpiRes, pg8::StaticOrder, true, SP2V>(lds, g, S, E2); }
            EpiRes E{p.ws, WS_SSQA, WS_XB};
            pg8::gemm_phase<EpiRes, pg8::StaticOrder, true, SP2V>(lds, g, S, E);
            for (int tile = bid; tile < 256; tile += G)
                small_res_gemm(lds, WSP(bf16_t, WS_ACT) + (size_t)MP * DFF, WSP(bf16_t, WS_WDN) + (size_t)L * DM * DFF, DFF, WSP(bf16_t, WS_XB) + (size_t)MP * DM, WSP(float, WS_SSQA) + (size_t)MP * 16, tile);
        }
        SEAM(P0 + 4);
    }
    if (IN(21)) {
        const int gw = bid * 8 + wave, NGW = G * 8;
        const bf16_t* XB = WSP(bf16_t, WS_XB); const float* g_final = p.in[20]; float* out = p.out;
        for (int row0 = gw; row0 < MTOT; row0 += 2 * NGW) {
            const int row1 = row0 + NGW; const bool has1 = row1 < MTOT;
            const float rs0 = rstd16(WSP(float, WS_SSQA), row0), rs1 = has1 ? rstd16(WSP(float, WS_SSQA), row1) : 0.f;
            u32x2 x0[4], x1[4];
#pragma unroll
            for (int j = 0; j < 4; ++j) { x0[j] = *(const u32x2*)(XB + (size_t)row0 * DM + j * 256 + lane * 4); x1[j] = has1 ? *(const u32x2*)(XB + (size_t)row1 * DM + j * 256 + lane * 4) : (u32x2){0u, 0u}; }
#pragma unroll
            for (int j = 0; j < 4; ++j) { const int c = j * 256 + lane * 4; const f32x4 gv = *(const f32x4*)(g_final + c);
                *(f32x4*)(out + (size_t)row0 * DM + c) = unpack4(x0[j]) * rs0 * gv;
                if (has1) *(f32x4*)(out + (size_t)row1 * DM + c) = unpack4(x1[j]) * rs1 * gv; }
        }
    }
#undef IN
#undef SEAM
#undef WSP
}

extern "C" void kernel_launch(void* const* d_in, const int* in_sizes, int n_in, void* d_out, int out_size, void* d_ws, size_t ws_size, hipStream_t stream) {
    static int grid = 0;
    if (grid == 0) {
        if (n_in != 21 || (size_t)out_size != O_END || ws_size < (DUP ? WS_DEND : WS_END)) { fprintf(stderr, "kernel_launch: unexpected sizes n_in %d out %d ws %zu (need %zu)\n", n_in, out_size, ws_size, (size_t)WS_END); grid = -1; return; }
        int dev = 0, cus = 0, per_cu = 0;
        hipGetDevice(&dev); hipDeviceGetAttribute(&cus, hipDeviceAttributeMultiprocessorCount, dev);
        if (hipFuncSetAttribute((const void*)mega, hipFuncAttributeMaxDynamicSharedMemorySize, LDS_BYTES) != hipSuccess) { fprintf(stderr, "kernel_launch: hipFuncSetAttribute failed\n"); grid = -1; return; }
        if (hipOccupancyMaxActiveBlocksPerMultiprocessor(&per_cu, (const void*)mega, 512, LDS_BYTES) != hipSuccess || per_cu < 1) { fprintf(stderr, "kernel_launch: occupancy query says %d\n", per_cu); per_cu = 1; }
        (void)hipGetLastError();
        grid = cus * 1;
    }
    if (grid < 0) return;
    Params p{};
    for (int i = 0; i < 21; ++i) p.in[i] = (const float*)d_in[i];
    p.out = (float*)d_out; p.ws = (unsigned char*)d_ws;
#if ONE_LAUNCH
    if (hipMemsetAsync((char*)d_ws + WS_KNMAX, 0, (WS_BAR - WS_KNMAX) + 16384, stream) != hipSuccess) { fprintf(stderr, "kernel_launch: memset failed\n"); return; }
    p.ph_lo = 0; p.ph_hi = N_PHASES;
    void* args[] = {&p};
    hipError_t e = hipLaunchCooperativeKernel((void*)mega, dim3(grid), dim3(512), args, LDS_BYTES, stream);
    if (e != hipSuccess) fprintf(stderr, "cooperative launch failed: %s (grid %d)\n", hipGetErrorString(e), grid);
#else
    for (int ph = 0; ph < N_PHASES; ++ph) {
        p.ph_lo = ph; p.ph_hi = ph + 1;
        hipLaunchKernelGGL(mega, dim3(grid), dim3(512), LDS_BYTES, stream, p);
    }
#endif
}
```

```cpp
#include <hip/hip_runtime.h>
#include <hip/hip_cooperative_groups.h>
#include <cstdio>
#include <cstdint>
namespace cg = cooperative_groups;

#ifndef ONE_LAUNCH
#define ONE_LAUNCH 1
#endif

#ifndef SP2V
#define SP2V true
#endif
#ifndef DUP
#define DUP 0
#endif
#ifndef NO_PIN
#define NO_PIN 0
#endif
#ifndef NO_ATT
#define NO_ATT 0
#endif
#ifndef NO_POUT
#define NO_POUT 0
#endif
#ifndef NO_PGU
#define NO_PGU 0
#endif
#ifndef NO_PDN
#define NO_PDN 0
#endif
#ifndef NO_P0
#define NO_P0 0
#endif
#define LAS __attribute__((address_space(3)))
typedef unsigned short bf16_t;
typedef short bf16x8 __attribute__((ext_vector_type(8)));
typedef short s16x4 __attribute__((ext_vector_type(4)));
typedef float f32x4 __attribute__((ext_vector_type(4)));
typedef float f32x16 __attribute__((ext_vector_type(16)));
typedef unsigned u32x4 __attribute__((ext_vector_type(4)));
typedef unsigned u32x2 __attribute__((ext_vector_type(2)));

constexpr int DM = 1024, SEQ = 2048, NB = 8, DSEQ = 64, PAST = 2048, NH = 12, HD = 64, NMH = 4, NMEM = 256, DFF = 2816;
constexpr int MP = NB * SEQ;
constexpr int MS = NB * DSEQ;
constexpr int MTOT = MP + MS;
constexpr int MIXW = 768;
constexpr int NIN_PAD = 2816;
constexpr float EPS = 1e-6f;
constexpr float LOG2E = 1.4426950408889634f;
constexpr float QSCALE = 0.125f * LOG2E;

constexpr size_t O_YP = 0;
constexpr size_t O_YS = O_YP + (size_t)MP * DM;
constexpr size_t O_FKP = O_YS + (size_t)MS * DM;
constexpr size_t KVP_L = (size_t)MP * MIXW;
constexpr size_t O_FVP = O_FKP + 2 * KVP_L;
constexpr size_t O_FLP = O_FVP + 2 * KVP_L;
constexpr size_t O_SKP = O_FLP + 2 * (size_t)MP * NH;
constexpr size_t O_SVP = O_SKP + 2 * KVP_L;
constexpr size_t O_MKP = O_SVP + 2 * KVP_L;
constexpr size_t MKV_L = (size_t)NB * NMEM * 256;
constexpr size_t O_MVP = O_MKP + 4 * MKV_L;
constexpr size_t O_FKS = O_MVP + 4 * MKV_L;
constexpr size_t KVS_L = (size_t)MS * MIXW;
constexpr size_t O_FVS = O_FKS + 2 * KVS_L;
constexpr size_t O_FLS = O_FVS + 2 * KVS_L;
constexpr size_t O_SKS = O_FLS + 2 * (size_t)MS * NH;
constexpr size_t O_SVS = O_SKS + 2 * KVS_L;
constexpr size_t O_END = O_SVS + 2 * KVS_L;

constexpr size_t al256(size_t x) { return (x + 255) & ~(size_t)255; }
constexpr size_t WS_CTR = 0;
constexpr size_t WS_KNMAX = 2048;
constexpr size_t WS_BAR = 4096;
constexpr size_t WS_WIN = 32768;
constexpr size_t WS_WOUT = WS_WIN + (size_t)4 * NIN_PAD * DM * 2;
constexpr size_t WS_WGU = WS_WOUT + (size_t)4 * DM * DM * 2;
constexpr size_t WS_WDN = WS_WGU + (size_t)4 * 2 * DFF * DM * 2;
constexpr size_t WS_WMKV = WS_WDN + (size_t)4 * DM * DFF * 2;
constexpr size_t WS_XB = WS_WMKV + (size_t)4 * 512 * DM * 2;
constexpr size_t WS_XF = WS_XB + (size_t)MTOT * DM * 2;
constexpr size_t WS_QHP = WS_XF + (size_t)MTOT * DM * 4;
constexpr size_t WS_QHS = WS_QHP + (size_t)NB * NH * SEQ * HD * 2;
constexpr size_t WS_QMP = WS_QHS + (size_t)NB * NH * DSEQ * HD * 2;
constexpr size_t WS_QMS = WS_QMP + (size_t)NB * NMH * SEQ * HD * 2;
constexpr size_t WS_KH = WS_QMS + (size_t)NB * NMH * DSEQ * HD * 2;
constexpr size_t WS_VT = WS_KH + (size_t)NB * NH * SEQ * HD * 2;
constexpr size_t WS_OB = WS_VT + (size_t)NB * NH * SEQ * HD * 2;
constexpr size_t WS_ACT = WS_OB + (size_t)MTOT * DM * 2;
constexpr size_t WS_MPB = WS_ACT + (size_t)MTOT * DFF * 2;
constexpr size_t WS_MKB = WS_MPB + (size_t)NB * NMEM * DM * 2;
constexpr size_t WS_MVT = WS_MKB + (size_t)4 * NB * NMH * NMEM * HD * 2;
constexpr size_t WS_SSQA = WS_MVT + (size_t)4 * NB * NMH * NMEM * HD * 2;
constexpr size_t WS_SSQB = WS_SSQA + (size_t)MTOT * 16 * 4;
constexpr size_t WS_RSTDM = WS_SSQB + (size_t)MTOT * 16 * 4;
constexpr size_t WS_END = al256(WS_RSTDM + (size_t)NB * NMEM * 4);
constexpr size_t WS_DXF = WS_END, WS_DXB = WS_DXF + (size_t)MTOT * DM * 4, WS_DSSQ = WS_DXB + (size_t)MTOT * DM * 2, WS_DEND = WS_DSSQ + (size_t)MTOT * 16 * 4;

typedef float f32x2_t __attribute__((ext_vector_type(2))); typedef __bf16 bf16x2_t __attribute__((ext_vector_type(2)));
__device__ __forceinline__ unsigned cvt_pk_bf16(float lo, float hi) { const f32x2_t v = {lo, hi}; const bf16x2_t b = __builtin_convertvector(v, bf16x2_t); return __builtin_bit_cast(unsigned, b); }
__device__ __forceinline__ u32x2 pack4(f32x4 v) { u32x2 w; w.x = cvt_pk_bf16(v[0], v[1]); w.y = cvt_pk_bf16(v[2], v[3]); return w; }
__device__ __forceinline__ u32x4 pack8(f32x4 a, f32x4 b) { u32x4 w; w.x = cvt_pk_bf16(a[0], a[1]); w.y = cvt_pk_bf16(a[2], a[3]); w.z = cvt_pk_bf16(b[0], b[1]); w.w = cvt_pk_bf16(b[2], b[3]); return w; }
__device__ __forceinline__ bf16_t f2bf(float f) { unsigned u = __builtin_bit_cast(unsigned, f); return (bf16_t)((u + 0x7fffu + ((u >> 16) & 1u)) >> 16); }

namespace pg8 {
#define PG8_LAS __attribute__((address_space(3)))
constexpr int BM = 256, BK = 64, HALF = 128, HTB = HALF * BK * 2, STAGE_BYTES = 8 * HTB, NXCD = 8, WGM = 8;
__host__ __device__ __forceinline__ int lds_byte(int r, int c) { const int st = (r >> 4) * 2 + (c >> 5), rr = r & 15, cc = c & 31, ob = rr * 64 + cc * 2; return st * 1024 + (ob ^ (((ob >> 9) & 1) << 5)); }
__host__ __device__ __forceinline__ void stage_rc(int b, int& R, int& C) { const int st = b / 1024, sb = b % 1024, swz = sb ^ (((sb >> 9) & 1) << 5); R = (st >> 1) * 16 + swz / 64; C = (st & 1) * 32 + (swz % 64) / 2; }
__host__ __device__ __forceinline__ int perm32(int rho) { const int n = rho >> 4, i = rho & 15; return 8 * (i >> 2) + 4 * n + (i & 3); }
struct Unit { int pm, pn; };
struct Gemm { const bf16_t* A; const bf16_t* Bt; int M, N, K; };
struct StaticOrder {
    int nM, nN, nwg, G, c;
    __host__ __device__ void init(int M, int N, int G_, int c_) { nM = M / BM; nN = N / BM; nwg = nM * nN; G = G_; c = c_; }
    __host__ __device__ bool next(int i, Unit& u) const {
        const long L = (long)i * G + c; if (L >= nwg) return false;
        int wgid = (int)L; { const int q = nwg / NXCD, r = nwg % NXCD, xcd = wgid % NXCD, off = wgid / NXCD; wgid = (xcd < r ? xcd * (q + 1) : r * (q + 1) + (xcd - r) * q) + off; }
        const int nig = WGM * nN, gid = wgid / nig, fm = gid * WGM, gsz = (nM - fm) < WGM ? (nM - fm) : WGM;
        u.pm = fm + ((wgid % nig) % gsz); u.pn = (wgid % nig) / gsz; return true;
    }
    __device__ __forceinline__ void a_ready(const Unit&) const {}
    __device__ __forceinline__ void done(const Unit&) const {}
};

template <class Epi, class Sched, bool ALIGN_EPI = false, bool SP2 = false>
__device__ __forceinline__ void gemm_phase(PG8_LAS unsigned char* lds, const Gemm g, const Sched& S, const Epi& E) {
    int tid_ = threadIdx.x; asm volatile("" : "+v"(tid_));
    const int tid = tid_, wid = __builtin_amdgcn_readfirstlane(tid >> 6), lane = tid & 63, wr = wid >> 2, wc = wid & 3, fr = lane & 15, fq = lane >> 4;
    const int K = g.K, nt = K / BK;
    unsigned voffA[2], voffB[2];
#pragma unroll
    for (int i = 0; i < 2; ++i) { int R, C; stage_rc(tid * 16 + i * 8192, R, C); const int Rb = Epi::PERM ? ((R & ~31) + perm32(R & 31)) : R;
        voffA[i] = (unsigned)(R * K + C) * 2u; voffB[i] = (unsigned)(Rb * K + C) * 2u; }
    const size_t kstep = (size_t)(BK * 2);
    const size_t hstep = (size_t)HALF * K * 2;
    const size_t tstep = 2 * hstep;
    const unsigned ldsw = (unsigned)wid * 1024u;
    const int aoff = lds_byte(wr * 64 + fr, fq * 8), boff = lds_byte(wc * 32 + fr, fq * 8);
#define PG8_SA(b, h) (((b) * 2 + (h)) * HTB)
#define PG8_SB(b, h) ((4 + (b) * 2 + (h)) * HTB)
#define PG8_STAGE(bufoff, gbase, voff) do { _Pragma("unroll") for (int _i = 0; _i < 2; ++_i) \
        __builtin_amdgcn_global_load_lds((const unsigned*)((const char*)(gbase) + (voff)[_i]), (PG8_LAS unsigned*)(lds + (bufoff) + ldsw + _i * 8192), 16, 0, 0); } while (0)
#define PG8_LDA(dst, b, h) do { _Pragma("unroll") for (int m = 0; m < 4; ++m) _Pragma("unroll") for (int k = 0; k < 2; ++k) dst[m][k] = *(const PG8_LAS bf16x8*)(lds + PG8_SA(b, h) + aoff + m * 2048 + k * 1024); } while (0)
#define PG8_LDB(dst, b, h) do { _Pragma("unroll") for (int n = 0; n < 2; ++n) _Pragma("unroll") for (int k = 0; k < 2; ++k) dst[n][k] = *(const PG8_LAS bf16x8*)(lds + PG8_SB(b, h) + boff + n * 2048 + k * 1024); } while (0)
#define PG8_MMA(ai, bj, At, Bt) do { __builtin_amdgcn_s_setprio(1); _Pragma("unroll") for (int m = 0; m < 4; ++m) _Pragma("unroll") for (int n = 0; n < 2; ++n) _Pragma("unroll") for (int k = 0; k < 2; ++k) \
        acc[ai][bj][m][n] = __builtin_amdgcn_mfma_f32_16x16x32_bf16(Bt[n][k], At[m][k], acc[ai][bj][m][n], 0, 0, 0); __builtin_amdgcn_s_setprio(0); } while (0)
#define PG8_WAIT_V(n) asm volatile("s_waitcnt vmcnt(" #n ")" ::: "memory")
#define PG8_WAIT_L(n) asm volatile("s_waitcnt lgkmcnt(" #n ")" ::: "memory")
#define PG8_BAR __builtin_amdgcn_s_barrier()
#define PG8_SCHED __builtin_amdgcn_sched_barrier(0)
    Unit cur, nxt; int ui = 0;
    if (!S.next(0, cur)) return;
    f32x4 acc[2][2][4][2];
#pragma unroll
    for (int a = 0; a < 2; ++a)
#pragma unroll
        for (int b = 0; b < 2; ++b)
#pragma unroll
            for (int m = 0; m < 4; ++m)
#pragma unroll
                for (int n = 0; n < 2; ++n) acc[a][b][m][n] = (f32x4){0.f, 0.f, 0.f, 0.f};
    bf16x8 At[4][2], B0[2][2], B1[2][2];
    const char* cA = (const char*)g.A + (size_t)cur.pm * tstep; const char* cB = (const char*)g.Bt + (size_t)cur.pn * tstep;
    S.a_ready(cur);
    if constexpr (SP2) {
        PG8_STAGE(PG8_SB(0, 0), cB, voffB); PG8_STAGE(PG8_SB(0, 1), cB + hstep, voffB); PG8_STAGE(PG8_SA(0, 0), cA, voffA); PG8_STAGE(PG8_SA(0, 1), cA + hstep, voffA);
        if (wr == 1) PG8_BAR;
        PG8_WAIT_V(2); PG8_BAR;
        PG8_STAGE(PG8_SB(1, 0), cB + kstep, voffB); PG8_STAGE(PG8_SA(1, 0), cA + kstep, voffA); PG8_STAGE(PG8_SB(1, 1), cB + hstep + kstep, voffB);
        PG8_WAIT_V(6); PG8_BAR;
    } else {
        PG8_STAGE(PG8_SB(0, 0), cB, voffB); PG8_STAGE(PG8_SA(0, 0), cA, voffA); PG8_STAGE(PG8_SB(0, 1), cB + hstep, voffB); PG8_STAGE(PG8_SA(0, 1), cA + hstep, voffA);
        if (wr == 1) PG8_BAR;
        PG8_WAIT_V(4); PG8_BAR;
        PG8_STAGE(PG8_SB(1, 0), cB + kstep, voffB); PG8_STAGE(PG8_SA(1, 0), cA + kstep, voffA); PG8_STAGE(PG8_SB(1, 1), cB + hstep + kstep, voffB);
        PG8_WAIT_V(6); PG8_BAR;
    }
    for (;;) {
        const bool has_next = S.next(ui + 1, nxt);
        const char* nA = has_next ? (const char*)g.A + (size_t)nxt.pm * tstep : cA; const char* nB = has_next ? (const char*)g.Bt + (size_t)nxt.pn * tstep : cB;
        for (int t = 0; t < nt; t += 2) {
            const bool last = (t == nt - 2);
            const char* a1 = cA + (size_t)(t + 1) * kstep;
            const char* a2 = last ? nA : cA + (size_t)(t + 2) * kstep; const char* b2 = last ? nB : cB + (size_t)(t + 2) * kstep;
            const char* a3 = a2 + kstep; const char* b3 = b2 + kstep;
            if (last && has_next) S.a_ready(nxt);
            if constexpr (SP2) {
            PG8_LDB(B0, 0, 0); PG8_LDB(B1, 0, 1); PG8_SCHED; PG8_LDA(At, 0, 0); PG8_STAGE(PG8_SA(1, 1), a1 + hstep, voffA);
            PG8_WAIT_V(8); PG8_WAIT_L(0); PG8_BAR; PG8_MMA(0, 0, At, B0); PG8_MMA(0, 1, At, B1); PG8_BAR; PG8_SCHED;
            PG8_LDA(At, 0, 1); PG8_STAGE(PG8_SB(0, 0), b2, voffB); PG8_STAGE(PG8_SB(0, 1), b2 + hstep, voffB); PG8_STAGE(PG8_SA(0, 0), a2, voffA);
            PG8_WAIT_V(8); PG8_WAIT_L(0); PG8_BAR; PG8_MMA(1, 0, At, B0); PG8_MMA(1, 1, At, B1); PG8_BAR; PG8_SCHED;
            PG8_LDB(B0, 1, 0); PG8_LDB(B1, 1, 1); PG8_SCHED; PG8_LDA(At, 1, 0); PG8_STAGE(PG8_SA(0, 1), a2 + hstep, voffA);
            PG8_WAIT_V(8); PG8_WAIT_L(0); PG8_BAR; PG8_MMA(0, 0, At, B0); PG8_MMA(0, 1, At, B1); PG8_BAR; PG8_SCHED;
            PG8_LDA(At, 1, 1); PG8_STAGE(PG8_SB(1, 0), b3, voffB); PG8_STAGE(PG8_SB(1, 1), b3 + hstep, voffB); PG8_STAGE(PG8_SA(1, 0), a3, voffA);
            PG8_WAIT_V(8); PG8_WAIT_L(0); PG8_BAR; PG8_MMA(1, 0, At, B0); PG8_MMA(1, 1, At, B1); PG8_BAR; PG8_SCHED;
            } else {
            PG8_LDB(B0, 0, 0); PG8_SCHED; PG8_LDA(At, 0, 0); PG8_STAGE(PG8_SA(1, 1), a1 + hstep, voffA);
            PG8_WAIT_L(8); PG8_BAR; PG8_WAIT_L(0); PG8_MMA(0, 0, At, B0); PG8_BAR; PG8_SCHED;
            PG8_LDB(B1, 0, 1); PG8_STAGE(PG8_SB(0, 0), b2, voffB);
            PG8_BAR; PG8_WAIT_L(0); PG8_MMA(0, 1, At, B1); PG8_BAR;
            PG8_LDA(At, 0, 1); PG8_STAGE(PG8_SA(0, 0), a2, voffA);
            PG8_BAR; PG8_WAIT_L(0); PG8_MMA(1, 0, At, B0); PG8_BAR; PG8_SCHED;
            PG8_STAGE(PG8_SB(0, 1), b2 + hstep, voffB);
            PG8_WAIT_V(6); PG8_BAR; PG8_MMA(1, 1, At, B1); PG8_BAR;
            PG8_LDB(B0, 1, 0); PG8_SCHED; PG8_LDA(At, 1, 0); PG8_STAGE(PG8_SA(0, 1), a2 + hstep, voffA);
            PG8_WAIT_L(8); PG8_BAR; PG8_WAIT_L(0); PG8_MMA(0, 0, At, B0); PG8_BAR; PG8_SCHED;
            PG8_LDB(B1, 1, 1); PG8_STAGE(PG8_SB(1, 0), b3, voffB);
            PG8_BAR; PG8_WAIT_L(0); PG8_MMA(0, 1, At, B1); PG8_BAR;
            PG8_LDA(At, 1, 1); PG8_STAGE(PG8_SA(1, 0), a3, voffA);
            PG8_BAR; PG8_WAIT_L(0); PG8_MMA(1, 0, At, B0); PG8_BAR; PG8_SCHED;
            PG8_STAGE(PG8_SB(1, 1), b3 + hstep, voffB);
            PG8_WAIT_V(6); PG8_BAR; PG8_MMA(1, 1, At, B1); PG8_BAR;
            }
        }
        if constexpr (ALIGN_EPI) { if (wr == 0) PG8_BAR; }
        if constexpr (!Epi::AFTER_DRAIN) { E(acc, cur, wr, wc, fr, fq); S.done(cur); }
        if (!has_next) break;
#pragma unroll
        for (int a = 0; a < 2; ++a)
#pragma unroll
            for (int b = 0; b < 2; ++b)
#pragma unroll
                for (int m = 0; m < 4; ++m)
#pragma unroll
                    for (int n = 0; n < 2; ++n) acc[a][b][m][n] = (f32x4){0.f, 0.f, 0.f, 0.f};
        cur = nxt; cA = nA; cB = nB; ++ui;
        if constexpr (ALIGN_EPI) { if (wr == 1) PG8_BAR; }
    }
    PG8_WAIT_V(0);
    if constexpr (!ALIGN_EPI) { if (wr == 0) PG8_BAR; }
    PG8_BAR;
#undef PG8_SA
#undef PG8_SB
#undef PG8_STAGE
#undef PG8_LDA
#undef PG8_LDB
#undef PG8_MMA
#undef PG8_WAIT_V
#undef PG8_WAIT_L
#undef PG8_BAR
#undef PG8_SCHED
}
}

__device__ __forceinline__ float rstd16(const float* ssq, int row) {
    const f32x4* p = (const f32x4*)(ssq + (size_t)row * 16); const f32x4 a = p[0], b = p[1], c = p[2], d = p[3];
    const float s = ((a[0] + a[1]) + (a[2] + a[3])) + ((b[0] + b[1]) + (b[2] + b[3])) + ((c[0] + c[1]) + (c[2] + c[3])) + ((d[0] + d[1]) + (d[2] + d[3]));
    return rsqrtf(s * (1.0f / DM) + EPS);
}

__device__ __forceinline__ float rstd16c(const float* ssq, int row, int fq) {
    const f32x4 a = *(const f32x4*)(ssq + (size_t)row * 16 + fq * 4);
    float s = (a[0] + a[1]) + (a[2] + a[3]); s += __shfl_xor(s, 16); s += __shfl_xor(s, 32);
    return rsqrtf(s * (1.0f / DM) + EPS);
}

struct EpiIn {
    static constexpr bool PERM = true, AFTER_DRAIN = false;
    unsigned char* ws; float* out; const float* bf; int fox, j;
    __device__ __forceinline__ void operator()(const f32x4 (&acc)[2][2][4][2], const pg8::Unit& u, int wr, int wc, int fr_, int fq_) const {
        int fr = fr_, fq = fq_; asm volatile("" : "+v"(fr), "+v"(fq));
        const int pn = u.pn; const bool samp = (u.pm >= MP / 256);
        const float* ssq = (const float*)(ws + WS_SSQA);
        float kmx[2] = {0.f, 0.f};
        float rsv[2][4];
#pragma unroll
        for (int ai = 0; ai < 2; ++ai)
#pragma unroll
            for (int m = 0; m < 4; ++m) rsv[ai][m] = rstd16c(ssq, u.pm * 256 + ai * 128 + wr * 64 + m * 16 + fr, fq);
        asm volatile("" ::: "memory");
#pragma unroll
        for (int ai = 0; ai < 2; ++ai)
#pragma unroll
            for (int m = 0; m < 4; ++m) {
                const int row = u.pm * 256 + ai * 128 + wr * 64 + m * 16 + fr;
                const float rs = rsv[ai][m];
                int b, t, rl; if (!samp) { b = row >> 11; t = row & 2047; rl = row; } else { rl = row - MP; b = rl >> 6; t = rl & 63; }
                float kn2[2] = {0.f, 0.f};
#pragma unroll
                for (int bj = 0; bj < 2; ++bj) {
                    const int c = bj * 128 + wc * 32 + fq * 8;
                    f32x4 v0 = acc[ai][bj][m][0] * rs, v1 = acc[ai][bj][m][1] * rs;
                    if (pn < 3) {
                        const int cg_ = pn * 256 + c, h = cg_ >> 6, d = cg_ & 63; v0 = v0 * QSCALE; v1 = v1 * QSCALE;
                        bf16_t* dst = samp ? (bf16_t*)(ws + WS_QHS) + ((size_t)(b * NH + h) * DSEQ + t) * HD + d : (bf16_t*)(ws + WS_QHP) + ((size_t)(b * NH + h) * SEQ + t) * HD + d;
                        *(u32x4*)dst = pack8(v0, v1);
                    } else if (pn == 9) {
                        const int mh = c >> 6, d = c & 63; v0 = v0 * QSCALE; v1 = v1 * QSCALE;
                        bf16_t* dst = samp ? (bf16_t*)(ws + WS_QMS) + ((size_t)(b * NMH + mh) * DSEQ + t) * HD + d : (bf16_t*)(ws + WS_QMP) + ((size_t)(b * NMH + mh) * SEQ + t) * HD + d;
                        *(u32x4*)dst = pack8(v0, v1);
                    } else if (pn < 9) {
                        const bool isv = pn >= 6;
                        const int cg_ = (pn - (isv ? 6 : 3)) * 256 + c, h = cg_ >> 6, d = cg_ & 63;
                        const size_t obase = samp ? (fox ? (isv ? O_FVS : O_FKS) : (isv ? O_SVS : O_SKS)) + (size_t)j * KVS_L : (fox ? (isv ? O_FVP : O_FKP) : (isv ? O_SVP : O_SKP)) + (size_t)j * KVP_L;
                        float* op = out + obase + (size_t)rl * MIXW + cg_;
                        *(f32x4*)op = v0; *(f32x4*)(op + 4) = v1;
                        if (!isv) kn2[bj] += ((v0[0] * v0[0] + v0[1] * v0[1]) + (v0[2] * v0[2] + v0[3] * v0[3])) + ((v1[0] * v1[0] + v1[1] * v1[1]) + (v1[2] * v1[2] + v1[3] * v1[3]));
                        if (!samp) *(u32x4*)((bf16_t*)(ws + (isv ? WS_VT : WS_KH)) + ((size_t)(b * NH + h) * SEQ + t) * HD + d) = pack8(v0, v1);
                    } else {
                        if (bj == 0 && wc == 0 && fq < 2) {
                            float* olf = out + (samp ? O_FLS + (size_t)j * MS * NH : O_FLP + (size_t)j * MP * NH);
#pragma unroll
                            for (int n = 0; n < 2; ++n) if (fq == 0 || n == 0) {
#pragma unroll
                                for (int jj = 0; jj < 4; ++jj) { const int hh = fq * 8 + n * 4 + jj; const float x = (n == 0 ? v0[jj] : v1[jj]) + bf[hh];
                                    const float lf = fminf(x, 0.f) - log1pf(expf(-fabsf(x)));
                                    olf[(size_t)rl * NH + hh] = lf; }
                            }
                        }
                    }
                }
                if (fox && !samp && pn >= 3 && pn < 6) {
#pragma unroll
                    for (int bj = 0; bj < 2; ++bj) { float q2 = kn2[bj]; q2 += __shfl_xor(q2, 16); q2 += __shfl_xor(q2, 32); kmx[bj] = fmaxf(kmx[bj], q2); }
                }
            }
        if (fox && !samp && pn >= 3 && pn < 6) {
            const int b = (u.pm * 256) >> 11;
#pragma unroll
            for (int bj = 0; bj < 2; ++bj) { float mx = kmx[bj]; mx = fmaxf(mx, __shfl_xor(mx, 1)); mx = fmaxf(mx, __shfl_xor(mx, 2)); mx = fmaxf(mx, __shfl_xor(mx, 4)); mx = fmaxf(mx, __shfl_xor(mx, 8));
                const int head = (pn - 3) * 4 + bj * 2 + (wc >> 1);
                if (fr == 0 && fq == 0) atomicMax((unsigned*)(ws + WS_KNMAX) + ((size_t)(j * NB + b) * NH + head) * 2 + (wc & 1), __float_as_uint(mx)); }
        }
    }
};

struct EpiMKV {
    static constexpr bool PERM = true, AFTER_DRAIN = false;
    unsigned char* ws; float* out; int layer0;
    __device__ __forceinline__ void operator()(const f32x4 (&acc)[2][2][4][2], const pg8::Unit& u, int wr, int wc, int fr_, int fq_) const {
        int fr = fr_, fq = fq_; asm volatile("" : "+v"(fr), "+v"(fq));
        const int layer = layer0 + (u.pn >> 1); const bool isv = (u.pn & 1);
        const float* rstdm = (const float*)(ws + WS_RSTDM);
        float rsv[2][4];
#pragma unroll
        for (int ai = 0; ai < 2; ++ai)
#pragma unroll
            for (int m = 0; m < 4; ++m) rsv[ai][m] = rstdm[u.pm * 256 + ai * 128 + wr * 64 + m * 16 + fr];
        asm volatile("" ::: "memory");
#pragma unroll
        for (int ai = 0; ai < 2; ++ai)
#pragma unroll
            for (int m = 0; m < 4; ++m) {
                const int row = u.pm * 256 + ai * 128 + wr * 64 + m * 16 + fr; const int b = row >> 8, mm = row & 255;
                const float rs = rsv[ai][m];
#pragma unroll
                for (int bj = 0; bj < 2; ++bj) {
                    const int c = bj * 128 + wc * 32 + fq * 8; const int mh = c >> 6, d = c & 63;
                    const f32x4 v0 = acc[ai][bj][m][0] * rs, v1 = acc[ai][bj][m][1] * rs;
                    float* op = out + (isv ? O_MVP : O_MKP) + ((size_t)layer * (NB * NMEM) + row) * 256 + c;
                    *(f32x4*)op = v0; *(f32x4*)(op + 4) = v1;
                    *(u32x4*)((bf16_t*)(ws + (isv ? WS_MVT : WS_MKB)) + ((size_t)((layer * NB + b) * NMH + mh) * NMEM + mm) * HD + d) = pack8(v0, v1);
                }
            }
    }
};

__device__ __forceinline__ f32x4 unpack4(u32x2 w) { return (f32x4){__uint_as_float(w.x << 16), __uint_as_float(w.x & 0xffff0000u), __uint_as_float(w.y << 16), __uint_as_float(w.y & 0xffff0000u)}; }
struct EpiRes {
    static constexpr bool PERM = true, AFTER_DRAIN = false;
    unsigned char* ws; size_t ssq_off, xb_off;
    __device__ __forceinline__ void operator()(f32x4 (&acc)[2][2][4][2], const pg8::Unit& u, int wr, int wc, int fr_, int fq_) const {
        int fr = fr_, fq = fq_; asm volatile("" : "+v"(fr), "+v"(fq));
        const bf16_t* src = (const bf16_t*)(ws + WS_XB); bf16_t* xb = (bf16_t*)(ws + xb_off); float* ssq_out = (float*)(ws + ssq_off);
        const unsigned off0 = (unsigned)((u.pm * 256 + wr * 64 + fr) * DM + u.pn * 256 + wc * 32 + fq * 8);
        u32x4 r[2][4][2];
#pragma unroll
        for (int ai = 0; ai < 2; ++ai)
#pragma unroll
            for (int m = 0; m < 4; ++m)
#pragma unroll
                for (int bj = 0; bj < 2; ++bj) r[ai][m][bj] = *(const u32x4*)(src + off0 + (unsigned)((ai * 128 + m * 16) * DM + bj * 128));
#pragma unroll
        for (int ai = 0; ai < 2; ++ai)
#pragma unroll
            for (int m = 0; m < 4; ++m)
#pragma unroll
                for (int bj = 0; bj < 2; ++bj) { const u32x4 w = r[ai][m][bj]; acc[ai][bj][m][0] += unpack4((u32x2){w.x, w.y}); acc[ai][bj][m][1] += unpack4((u32x2){w.z, w.w}); }
        asm volatile("" ::: "memory");
#pragma unroll
        for (int ai = 0; ai < 2; ++ai)
#pragma unroll
            for (int m = 0; m < 4; ++m) {
                const int row = u.pm * 256 + ai * 128 + wr * 64 + m * 16 + fr;
                float ss = 0.f;
#pragma unroll
                for (int bj = 0; bj < 2; ++bj) {
                    const f32x4 v0 = acc[ai][bj][m][0], v1 = acc[ai][bj][m][1];
                    *(u32x4*)(xb + off0 + (unsigned)((ai * 128 + m * 16) * DM + bj * 128)) = pack8(v0, v1);
                    ss += ((v0[0] * v0[0] + v0[1] * v0[1]) + (v0[2] * v0[2] + v0[3] * v0[3])) + ((v1[0] * v1[0] + v1[1] * v1[1]) + (v1[2] * v1[2] + v1[3] * v1[3]));
                }
                ss += __shfl_xor(ss, 16); ss += __shfl_xor(ss, 32);
                if (fq == 0) ssq_out[(size_t)row * 16 + u.pn * 4 + wc] = ss;
            }
    }
};

struct EpiGU {
    static constexpr bool PERM = true, AFTER_DRAIN = false;
    unsigned char* ws;
    __device__ __forceinline__ void operator()(const f32x4 (&acc)[2][2][4][2], const pg8::Unit& u, int wr, int wc, int fr_, int fq_) const {
        int fr = fr_, fq = fq_; asm volatile("" : "+v"(fr), "+v"(fq));
        const float* ssq = (const float*)(ws + WS_SSQB); bf16_t* act = (bf16_t*)(ws + WS_ACT);
        float rsv[2][4];
#pragma unroll
        for (int ai = 0; ai < 2; ++ai)
#pragma unroll
            for (int m = 0; m < 4; ++m) rsv[ai][m] = rstd16c(ssq, u.pm * 256 + ai * 128 + wr * 64 + m * 16 + fr, fq);
        asm volatile("" ::: "memory");
#pragma unroll
        for (int ai = 0; ai < 2; ++ai)
#pragma unroll
            for (int m = 0; m < 4; ++m) {
                const int row = u.pm * 256 + ai * 128 + wr * 64 + m * 16 + fr;
                const float rs = rsv[ai][m];
                f32x4 a2[2];
#pragma unroll
                for (int n = 0; n < 2; ++n) {
                    const f32x4 g = acc[ai][0][m][n] * rs, up = acc[ai][1][m][n] * rs;
#pragma unroll
                    for (int j = 0; j < 4; ++j) a2[n][j] = g[j] * __builtin_amdgcn_rcpf(1.f + __expf(-g[j])) * up[j];
                }
                *(u32x4*)(act + (size_t)row * DFF + u.pn * 128 + wc * 32 + fq * 8) = pack8(a2[0], a2[1]);
            }
    }
};

__device__ __forceinline__ float wave_sum(float v) {
#pragma unroll
    for (int o = 1; o < 64; o <<= 1) v += __shfl_xor(v, o);
    return v;
}
__device__ __forceinline__ void tr_item(const float* src, int ldw, const float* g, bf16_t* dst, int ldk, int nvalid, LAS float* scr, int lane) {
    const int nn = lane & 31;
    float tv[32];
#pragma unroll
    for (int i = 0; i < 32; ++i) { const int kk = 2 * i + (lane >> 5); tv[i] = (nn < nvalid) ? src[(size_t)kk * ldw + nn] : 0.f; }
#pragma unroll
    for (int i = 0; i < 32; ++i) { const int kk = 2 * i + (lane >> 5); float v = tv[i]; if (g) v *= g[kk]; scr[kk * 33 + nn] = v; }
    asm volatile("s_waitcnt lgkmcnt(0)" ::: "memory");
    const int c = lane & 7;
#pragma unroll
    for (int j = 0; j < 4; ++j) { const int n = (lane >> 3) + 8 * j; const LAS float* s = scr + (8 * c) * 33 + n;
        u32x4 o; o.x = cvt_pk_bf16(s[0 * 33], s[1 * 33]); o.y = cvt_pk_bf16(s[2 * 33], s[3 * 33]); o.z = cvt_pk_bf16(s[4 * 33], s[5 * 33]); o.w = cvt_pk_bf16(s[6 * 33], s[7 * 33]);
        *(u32x4*)(dst + (size_t)n * ldk + 8 * c) = o; }
    asm volatile("s_waitcnt lgkmcnt(0)" ::: "memory");
}

__device__ __forceinline__ void small_res_gemm(LAS unsigned char* lds, const bf16_t* A, const bf16_t* Bt, int K, bf16_t* xb, float* ssq, int tile) {
    int tid_ = threadIdx.x; asm volatile("" : "+v"(tid_));
    const int tid = tid_, lane = tid & 63, wid = tid >> 6, fr = lane & 15, fq = lane >> 4;
    const int rt = tile >> 4, ct = tile & 15, row0 = rt * 32, colb = ct * 64;
    const int ksl = K >> 3, nsteps = ksl >> 5;
    const bf16_t* ap = A + (size_t)(row0 + fr) * K + wid * ksl + fq * 8; const bf16_t* bp = Bt + (size_t)(colb + fr) * K + wid * ksl + fq * 8;
    f32x4 acc[8];
#pragma unroll
    for (int n = 0; n < 8; ++n) acc[n] = (f32x4){0.f, 0.f, 0.f, 0.f};
    for (int s0 = 0; s0 < nsteps; s0 += 4) {
        bf16x8 a[4][2], b[4][4];
#pragma unroll
        for (int i = 0; i < 4; ++i) if (s0 + i < nsteps) {
#pragma unroll
            for (int rb = 0; rb < 2; ++rb) a[i][rb] = *(const bf16x8*)(ap + (size_t)rb * 16 * K + (s0 + i) * 32);
#pragma unroll
            for (int cb = 0; cb < 4; ++cb) b[i][cb] = *(const bf16x8*)(bp + (size_t)cb * 16 * K + (s0 + i) * 32); }
#pragma unroll
        for (int i = 0; i < 4; ++i) if (s0 + i < nsteps) {
#pragma unroll
            for (int rb = 0; rb < 2; ++rb)
#pragma unroll
                for (int cb = 0; cb < 4; ++cb) acc[rb * 4 + cb] = __builtin_amdgcn_mfma_f32_16x16x32_bf16(a[i][rb], b[i][cb], acc[rb * 4 + cb], 0, 0, 0); }
    }
    LAS f32x4* part = (LAS f32x4*)lds;
    LAS float* red = (LAS float*)(lds + 65536);
#pragma unroll
    for (int n = 0; n < 8; ++n) part[(wid * 8 + n) * 64 + lane] = acc[n];
    __syncthreads();
    f32x4 tot = part[wid * 64 + lane];
#pragma unroll
    for (int w = 1; w < 8; ++w) tot += part[(w * 8 + wid) * 64 + lane];
    const int rb = wid >> 2, cb = wid & 3, rowb = row0 + rb * 16, col0 = colb + cb * 16;
    float ssp[4];
#pragma unroll
    for (int j = 0; j < 4; ++j) { const size_t o = (size_t)(rowb + fq * 4 + j) * DM + col0 + fr; const float v = __uint_as_float((unsigned)xb[o] << 16) + tot[j]; xb[o] = f2bf(v); ssp[j] = v * v; }
#pragma unroll
    for (int j = 0; j < 4; ++j) { ssp[j] += __shfl_xor(ssp[j], 1); ssp[j] += __shfl_xor(ssp[j], 2); ssp[j] += __shfl_xor(ssp[j], 4); ssp[j] += __shfl_xor(ssp[j], 8); }
    if (fr == 0) {
#pragma unroll
        for (int j = 0; j < 4; ++j) red[wid * 16 + fq * 4 + j] = ssp[j];
    }
    __syncthreads();
    if (tid < 32) { const int rbi = tid >> 4, ri = tid & 15;
        const float t = (red[(rbi * 4 + 0) * 16 + ri] + red[(rbi * 4 + 1) * 16 + ri]) + (red[(rbi * 4 + 2) * 16 + ri] + red[(rbi * 4 + 3) * 16 + ri]);
        ssq[(size_t)(row0 + tid) * 16 + ct] = t; }
    __syncthreads();
}

constexpr int KPITCH = 144, VPITCH = 192;
constexpr int A_KS = 0, A_VS = 2 * 64 * KPITCH, A_C2 = A_VS + 2 * 64 * VPITCH, A_SCAN = A_C2 + 2560 * 4, A_UNIT = A_SCAN + 64, A_FLAG = A_UNIT + 64, A_END = A_FLAG + 64;
constexpr float THR_SB = 32.f, THR_FOX = 40.f;
__device__ __forceinline__ int crow(int i, int h) { return (i & 3) + 8 * (i >> 2) + 4 * h; }

__device__ __forceinline__ void fox_cumsum(LAS float* c2, LAS float* scan, const float* A, int split, const float* B, int n) {
    int tid_ = threadIdx.x; asm volatile("" : "+v"(tid_));
    const int tid = tid_, lane = tid & 63, wid = tid >> 6;
    float v[5]; float s = 0.f; const int t0 = tid * 5;
#pragma unroll
    for (int e = 0; e < 5; ++e) { const int t = t0 + e; float x = 0.f; if (t < n) x = (t < split) ? A[(size_t)t * NH] : B[(size_t)(t - split) * NH]; s += x; v[e] = s; }
    float w = s;
#pragma unroll
    for (int off = 1; off < 64; off <<= 1) { const float y = __shfl_up(w, off); if (lane >= off) w += y; }
    if (lane == 63) scan[wid] = w;
    __syncthreads();
    float base = w - s;
    for (int k = 0; k < wid; ++k) base += scan[k];
#pragma unroll
    for (int e = 0; e < 5; ++e) { const int t = t0 + e; if (t < n) c2[t] = (base + v[e]) * LOG2E; }
    __syncthreads();
}

typedef short v4i16_t __attribute__((ext_vector_type(4)));
__device__ __forceinline__ s16x4 vtr(const LAS unsigned char* p) { return __builtin_bit_cast(s16x4, __builtin_amdgcn_ds_read_tr16_b64_v4i16((LAS v4i16_t*)p)); }
template <bool SB>
__device__ __forceinline__ void att_tile(const LAS unsigned char* ks, const LAS unsigned char* vs, int kt, const LAS float* c2, int h, int r, const bf16x8 (&qf)[4], bool needmask, int qpos,
                                         float& mrun, float& lrun, float& Rc, f32x16& o0, f32x16& o1) {
            const int kv0 = 64 * kt;
            f32x16 p0, p1;
            if (!SB && c2) {
#pragma unroll
                for (int g = 0; g < 4; ++g) { const f32x4 ca = *(const LAS f32x4*)(c2 + kv0 + 8 * g + 4 * h), cb = *(const LAS f32x4*)(c2 + kv0 + 32 + 8 * g + 4 * h);
#pragma unroll
                    for (int e = 0; e < 4; ++e) { p0[4 * g + e] = -ca[e]; p1[4 * g + e] = -cb[e]; } }
            } else {
#pragma unroll
                for (int i = 0; i < 16; ++i) { p0[i] = 0.f; p1[i] = 0.f; }
            }
#pragma unroll
            for (int s = 0; s < 4; ++s) {
                const bf16x8 a0 = *(const LAS bf16x8*)(ks + r * KPITCH + 32 * s + 16 * h);
                const bf16x8 a1 = *(const LAS bf16x8*)(ks + (32 + r) * KPITCH + 32 * s + 16 * h);
                p0 = __builtin_amdgcn_mfma_f32_32x32x16_bf16(a0, qf[s], p0, 0, 0, 0);
                p1 = __builtin_amdgcn_mfma_f32_32x32x16_bf16(a1, qf[s], p1, 0, 0, 0);
            }
            if constexpr (!SB) {
                if (needmask) {
#pragma unroll
                    for (int i = 0; i < 16; ++i) { const int kv = kv0 + crow(i, h); if (kv > qpos) p0[i] = -1e30f; if (kv + 32 > qpos) p1[i] = -1e30f; }
                }
                float tm = fmaxf(p0[0], p1[0]);
#pragma unroll
                for (int i = 1; i < 16; ++i) tm = fmaxf(tm, fmaxf(p0[i], p1[i]));
                tm = fmaxf(tm, __shfl_xor(tm, 32));
                const float mnew = fmaxf(mrun, tm);
                {
                    const float alpha = __builtin_amdgcn_exp2f(mrun - mnew); mrun = mnew; lrun *= alpha;
#pragma unroll
                    for (int i = 0; i < 16; ++i) { o0[i] *= alpha; o1[i] *= alpha; }
                }
                float rsum = 0.f;
#pragma unroll
                for (int i = 0; i < 16; ++i) { p0[i] = __builtin_amdgcn_exp2f(p0[i] - mrun); p1[i] = __builtin_amdgcn_exp2f(p1[i] - mrun); rsum += p0[i] + p1[i]; }
                lrun += rsum;
            } else {
                f32x16 B0, B1;
#pragma unroll
                for (int i = 0; i < 16; ++i) {
                    const float e0 = __builtin_amdgcn_exp2f(fminf(p0[i], 80.f)), e1 = __builtin_amdgcn_exp2f(fminf(p1[i], 80.f));
                    float m0 = __builtin_amdgcn_rcpf(1.f + e0), m1 = __builtin_amdgcn_rcpf(1.f + e1);
                    float b0 = e0 * m0, b1 = e1 * m1;
                    if (needmask) { const int kv = kv0 + crow(i, h); if (kv >= qpos) { m0 = 1.f; b0 = 0.f; } if (kv + 32 >= qpos) { m1 = 1.f; b1 = 0.f; } }
                    p0[i] = m0; p1[i] = m1; B0[i] = b0; B1[i] = b1;
                }
                float T[8], To[8];
#pragma unroll
                for (int g = 0; g < 4; ++g) { T[g] = (p0[4 * g] * p0[4 * g + 1]) * (p0[4 * g + 2] * p0[4 * g + 3]); T[4 + g] = (p1[4 * g] * p1[4 * g + 1]) * (p1[4 * g + 2] * p1[4 * g + 3]); }
#pragma unroll
                for (int k = 0; k < 8; ++k) To[k] = __shfl_xor(T[k], 32);
                float rc = Rc;
#pragma unroll
                for (int k = 7; k >= 0; --k) {
                    const float w3 = rc * (h == 0 ? To[k] : 1.f);
                    const int g = k & 3;
                    if (k >= 4) { const float w2 = w3 * p1[4 * g + 3], w1 = w2 * p1[4 * g + 2], w0 = w1 * p1[4 * g + 1];
                        p1[4 * g + 3] = B1[4 * g + 3] * w3; p1[4 * g + 2] = B1[4 * g + 2] * w2; p1[4 * g + 1] = B1[4 * g + 1] * w1; p1[4 * g] = B1[4 * g] * w0; }
                    else { const float w2 = w3 * p0[4 * g + 3], w1 = w2 * p0[4 * g + 2], w0 = w1 * p0[4 * g + 1];
                        p0[4 * g + 3] = B0[4 * g + 3] * w3; p0[4 * g + 2] = B0[4 * g + 2] * w2; p0[4 * g + 1] = B0[4 * g + 1] * w1; p0[4 * g] = B0[4 * g] * w0; }
                    rc *= T[k] * To[k];
                }
                Rc = rc;
            }
            bf16x8 pf[4];
            { u32x4 w;
              w.x = cvt_pk_bf16(p0[0], p0[1]); w.y = cvt_pk_bf16(p0[2], p0[3]); w.z = cvt_pk_bf16(p0[4], p0[5]); w.w = cvt_pk_bf16(p0[6], p0[7]); pf[0] = __builtin_bit_cast(bf16x8, w);
              w.x = cvt_pk_bf16(p0[8], p0[9]); w.y = cvt_pk_bf16(p0[10], p0[11]); w.z = cvt_pk_bf16(p0[12], p0[13]); w.w = cvt_pk_bf16(p0[14], p0[15]); pf[1] = __builtin_bit_cast(bf16x8, w);
              w.x = cvt_pk_bf16(p1[0], p1[1]); w.y = cvt_pk_bf16(p1[2], p1[3]); w.z = cvt_pk_bf16(p1[4], p1[5]); w.w = cvt_pk_bf16(p1[6], p1[7]); pf[2] = __builtin_bit_cast(bf16x8, w);
              w.x = cvt_pk_bf16(p1[8], p1[9]); w.y = cvt_pk_bf16(p1[10], p1[11]); w.z = cvt_pk_bf16(p1[12], p1[13]); w.w = cvt_pk_bf16(p1[14], p1[15]); pf[3] = __builtin_bit_cast(bf16x8, w); }
            const LAS unsigned char* vtb = vs + (4 * h + ((r & 15) >> 2)) * VPITCH + (r >> 4) * 32 + (r & 3) * 8;
#pragma unroll
            for (int ps = 0; ps < 4; ++ps) {
                const s16x4 lo0 = vtr(vtb + (16 * ps) * VPITCH), hi0 = vtr(vtb + (16 * ps + 8) * VPITCH);
                const s16x4 lo1 = vtr(vtb + (16 * ps) * VPITCH + 64), hi1 = vtr(vtb + (16 * ps + 8) * VPITCH + 64);
                const bf16x8 va0 = (bf16x8){lo0[0], lo0[1], lo0[2], lo0[3], hi0[0], hi0[1], hi0[2], hi0[3]};
                const bf16x8 va1 = (bf16x8){lo1[0], lo1[1], lo1[2], lo1[3], hi1[0], hi1[1], hi1[2], hi1[3]};
                o0 = __builtin_amdgcn_mfma_f32_32x32x16_bf16(va0, pf[ps], o0, 0, 0, 0);
                o1 = __builtin_amdgcn_mfma_f32_32x32x16_bf16(va1, pf[ps], o1, 0, 0, 0);
            }
}

template <bool SB, bool F32>
__device__ __forceinline__ void attn_unit(LAS unsigned char* lds, const bf16_t* Q, int nq, int qpos0, const void* K1, const void* V1, int ld1,
                                          const float* K2, const float* V2, int ksplit, int ntile, bool causal, const LAS float* c2, bf16_t* O, float kmax,
                                          const float* csA = nullptr, int cs_split = 0, const float* csB = nullptr, int cs_n = 0) {
    int tid_ = threadIdx.x; asm volatile("" : "+v"(tid_));
    const int tid = tid_, lane = tid & 63, wid = __builtin_amdgcn_readfirstlane(tid >> 6), r = lane & 31, h = lane >> 5;
    const bool active = (wid * 32 < nq);
    bf16x8 qf[4];
#pragma unroll
    for (int s = 0; s < 4; ++s) qf[s] = active ? *(const bf16x8*)(Q + (size_t)(wid * 32 + r) * HD + 16 * s + 8 * h) : (bf16x8){0, 0, 0, 0, 0, 0, 0, 0};
    const int qmin = qpos0 + wid * 32, qmax = qmin + 31, qpos = qmin + r;
    const bool prune = SB || (kmax > 0.f);
    float qn = 0.f;
    if (!SB && prune) {
#pragma unroll
        for (int s_ = 0; s_ < 4; ++s_)
#pragma unroll
            for (int e = 0; e < 8; ++e) { const float f = __uint_as_float(((unsigned)(unsigned short)qf[s_][e]) << 16); qn += f * f; }
        qn += __shfl_xor(qn, 32); qn = sqrtf(qn) * kmax;
    }
    volatile LAS int* flags = (volatile LAS int*)(lds + A_FLAG);
    f32x16 o0, o1;
#pragma unroll
    for (int i = 0; i < 16; ++i) { o0[i] = 0.f; o1[i] = 0.f; }
    float mrun = -1e30f, lrun = 0.f, Rc = 1.f;
    u32x4 krA, vrA, krB, vrB; f32x4 kfA[2], vfA[2], kfB[2], vfB[2];
    const int srow = tid >> 3, sch = tid & 7;
#define ATT_LOAD(kt, X) do { if constexpr (F32) { _Pragma("unroll") for (int i_ = 0; i_ < 2; ++i_) { const int idx_ = tid + 512 * i_, row_ = idx_ >> 4, c4_ = idx_ & 15, key_ = (kt) * 64 + row_; \
            const float* kp_ = key_ < ksplit ? (const float*)K1 + (size_t)key_ * ld1 : K2 + (size_t)(key_ - ksplit) * ld1; \
            const float* vp_ = key_ < ksplit ? (const float*)V1 + (size_t)key_ * ld1 : V2 + (size_t)(key_ - ksplit) * ld1; \
            kf##X[i_] = *(const f32x4*)(kp_ + c4_ * 4); vf##X[i_] = *(const f32x4*)(vp_ + c4_ * 4); } } \
        else { kr##X = *(const u32x4*)((const bf16_t*)K1 + ((size_t)(kt) * 64 + srow) * HD + sch * 8); vr##X = *(const u32x4*)((const bf16_t*)V1 + ((size_t)(kt) * 64 + srow) * HD + sch * 8); } } while (0)
#define ATT_STORE(buf, X) do { LAS unsigned char* ks_ = lds + A_KS + (buf) * 64 * KPITCH; LAS unsigned char* vs_ = lds + A_VS + (buf) * 64 * VPITCH; \
        if constexpr (F32) { _Pragma("unroll") for (int i_ = 0; i_ < 2; ++i_) { const int idx_ = tid + 512 * i_, row_ = idx_ >> 4, c4_ = idx_ & 15; \
            *(LAS u32x2*)(ks_ + row_ * KPITCH + c4_ * 8) = pack4(kf##X[i_]); *(LAS u32x2*)(vs_ + row_ * VPITCH + c4_ * 8) = pack4(vf##X[i_]); } } \
        else { *(LAS u32x4*)(ks_ + srow * KPITCH + sch * 16) = kr##X; *(LAS u32x4*)(vs_ + srow * VPITCH + sch * 16) = vr##X; } } while (0)
#define ATT_STEP(IT, LD, ST) { const int it_ = (IT), kt = ntile - 1 - it_, buf = it_ & 1; \
        if (prune && it_ > 0) { volatile LAS int* fl = flags + ((it_ - 1) & 1) * 8; const int all_ = fl[0] & fl[1] & fl[2] & fl[3] & fl[4] & fl[5] & fl[6] & fl[7]; if (all_) break; } \
        if (it_ + 2 < ntile) ATT_LOAD(kt - 2, LD); \
        if (active && !(causal && 64 * kt > qmax)) \
            att_tile<SB>(lds + A_KS + buf * 64 * KPITCH, lds + A_VS + buf * 64 * VPITCH, kt, c2, h, r, qf, causal && (64 * kt + 63 >= qmin), qpos, mrun, lrun, Rc, o0, o1); \
        if (prune && kt > 0) { \
            bool done = true; \
            if (active) { \
                if constexpr (SB) done = __all(Rc < 2.3283064e-10f);   \
                else { const int kn = 64 * kt - 1; done = (kn < qmin) && __all(qn - c2[kn] < mrun - THR_FOX); } \
            } \
            if (lane == 0) flags[(it_ & 1) * 8 + wid] = done ? 1 : 0; \
        } \
        if (it_ + 1 < ntile) ATT_STORE(buf ^ 1, ST); \
        __syncthreads(); }
    ATT_LOAD(ntile - 1, A);
    if (csA) fox_cumsum((LAS float*)c2, (LAS float*)(lds + A_SCAN), csA, cs_split, csB, cs_n);
    ATT_STORE(0, A);
    if (ntile > 1) ATT_LOAD(ntile - 2, A);
    __syncthreads();
    for (int it = 0; it < ntile; it += 2) {
        ATT_STEP(it, B, A)
        if (it + 1 >= ntile) break;
        ATT_STEP(it + 1, A, B)
    }
#undef ATT_STEP
#undef ATT_LOAD
#undef ATT_STORE
    if (active) {
        float inv = 1.f;
        if constexpr (!SB) { const float lt = lrun + __shfl_xor(lrun, 32); inv = 1.f / lt; }
        bf16_t* orow = O + (size_t)(wid * 32 + r) * DM;
#pragma unroll
        for (int g = 0; g < 4; ++g) {
            f32x4 a = (f32x4){o0[4 * g], o0[4 * g + 1], o0[4 * g + 2], o0[4 * g + 3]} * inv, b = (f32x4){o1[4 * g], o1[4 * g + 1], o1[4 * g + 2], o1[4 * g + 3]} * inv;
            *(u32x2*)(orow + 8 * g + 4 * h) = pack4(a); *(u32x2*)(orow + 32 + 8 * g + 4 * h) = pack4(b);
        }
    }
}

#define XB_TMO      128
#define XB_XCNT(j)  (256  + 64 * (j))
#define XB_XSUB(j)  (1280 + 64 * (j))
#define XB_XGEN(j)  (2304 + 64 * (j))
#define XB_TOP      3328
#define XB_TOPGEN   3392
#define XCD_BAR_WORDS 3456
#define XB_SPIN_CAP (1u << 18)
__device__ __forceinline__ unsigned xb_ld(unsigned* p)              { return __hip_atomic_load(p, __ATOMIC_RELAXED, __HIP_MEMORY_SCOPE_AGENT); }
__device__ __forceinline__ unsigned xb_add(unsigned* p, unsigned v) { return __hip_atomic_fetch_add(p, v, __ATOMIC_RELAXED, __HIP_MEMORY_SCOPE_AGENT); }
__device__ __forceinline__ unsigned xb_xcc_id() { return (unsigned)__builtin_amdgcn_s_getreg((3 << 11) | 20) & 0xFu; }
#define XB_SPIN(cond, bar) do { unsigned _sp = 0; while (cond) { __builtin_amdgcn_s_sleep(1); \
    if ((++_sp & 255u) == 0u) { if (xb_ld(&(bar)[XB_TMO])) break; if (_sp > XB_SPIN_CAP) { atomicAdd(&(bar)[XB_TMO], 1u); break; } } } } while (0)
struct XcdBarrier { unsigned* bar; unsigned x; volatile LAS unsigned* st; };
__device__ __forceinline__ XcdBarrier xcd_barrier_post(unsigned* bar, volatile LAS unsigned* st) {
    XcdBarrier b; b.bar = bar; b.x = xb_xcc_id(); b.st = st;
    if (threadIdx.x == 0) (void)xb_add(&bar[XB_XCNT(b.x)], 1u);
    return b;
}
__device__ __forceinline__ void xcd_barrier_complete(unsigned* bar, unsigned x, unsigned& nloc, unsigned& nx) {
    const unsigned G = gridDim.x * gridDim.y * gridDim.z;
    unsigned sum, cnt, mine, sp = 0u;
    for (;;) {
        sum = 0u; cnt = 0u; mine = 0u;
#pragma unroll
        for (unsigned j = 0; j < 16; ++j) { const unsigned c = xb_ld(&bar[XB_XCNT(j)]); sum += c; cnt += (c > 0u) ? 1u : 0u; mine = (j == x) ? c : mine; }
        if (sum == G) break;
        __builtin_amdgcn_s_sleep(1);
        if ((++sp & 255u) == 0u) { if (xb_ld(&bar[XB_TMO])) break; if (sp > XB_SPIN_CAP) { atomicAdd(&bar[XB_TMO], 1u); break; } }
    }
    nloc = mine > 0u ? mine : 1u; nx = cnt > 0u ? cnt : 1u;
}
__device__ __forceinline__ void xcd_barrier(const XcdBarrier& b) {
    asm volatile("s_waitcnt vmcnt(0)" ::: "memory");
    __syncthreads();
    if (threadIdx.x == 0) {
        unsigned* bar = b.bar;
        __builtin_amdgcn_s_waitcnt(0);
        unsigned nloc = b.st[0], nx = b.st[1];
        if (nloc == 0u) { xcd_barrier_complete(bar, b.x, nloc, nx); b.st[0] = nloc; b.st[1] = nx; }
        const unsigned old = xb_add(&bar[XB_XSUB(b.x)], 1u);
        const unsigned gen = old / nloc;
        if (old + 1u == (gen + 1u) * nloc) {
            __builtin_amdgcn_fence(__ATOMIC_RELEASE, "agent");
            asm volatile("s_waitcnt vmcnt(0)" ::: "memory");
            const unsigned og = xb_add(&bar[XB_TOP], 1u);
            const unsigned tg = og / nx;
            if (og + 1u == (tg + 1u) * nx) xb_add(&bar[XB_TOPGEN], 1u);
            else XB_SPIN(xb_ld(&bar[XB_TOPGEN]) == tg, bar);
            __builtin_amdgcn_fence(__ATOMIC_ACQUIRE, "agent");
            xb_add(&bar[XB_XGEN(b.x)], 1u);
            asm volatile("s_waitcnt vmcnt(0)" ::: "memory");
        } else {
            XB_SPIN(xb_ld(&bar[XB_XGEN(b.x)]) == gen, bar);
            __builtin_amdgcn_fence(__ATOMIC_ACQUIRE, "agent");
            asm volatile("s_waitcnt vmcnt(0)" ::: "memory");
        }
    }
    __syncthreads();
}

struct Params { const float* in[21]; float* out; unsigned char* ws; int ph_lo, ph_hi; };
constexpr int LDS_BYTES = pg8::STAGE_BYTES + 4096;
constexpr int N_PHASES = 22;

__global__ void __launch_bounds__(512, 2) mega(Params p) {
    extern __shared__ __attribute__((aligned(16))) unsigned char lds_raw[];
    LAS unsigned char* lds = (LAS unsigned char*)lds_raw;
    const int tid = threadIdx.x, lane = tid & 63, wave = __builtin_amdgcn_readfirstlane(tid >> 6);
    const int G = gridDim.x, bid = blockIdx.x;
    const int lo = p.ph_lo, hi = p.ph_hi;
#define IN(k) (lo <= (k) && (k) < hi)
    volatile LAS unsigned* MISC = (volatile LAS unsigned*)(lds + pg8::STAGE_BYTES);
    if (tid < 2) MISC[tid] = 0u;
    __syncthreads();
    XcdBarrier xbar; xbar.bar = (unsigned*)(p.ws + WS_BAR); xbar.x = 0; xbar.st = MISC;
    if (ONE_LAUNCH) xbar = xcd_barrier_post((unsigned*)(p.ws + WS_BAR), MISC);
#define SEAM(k) do { if (IN(k) && IN((k) + 1)) { xcd_barrier(xbar); if (DUP & 64) { xcd_barrier(xbar); xcd_barrier(xbar); } } } while (0)
    if (lo < 0) cg::this_grid().sync();
#define WSP(T, off) ((T*)(p.ws + (off)))

    if (IN(0) && !NO_P0) for (int rep0 = 0; rep0 < ((DUP & 1) ? 2 : 1); ++rep0) {
        if (bid == 0 && tid < 16) WSP(unsigned, WS_CTR)[tid] = 0u;
        LAS float* scr = (LAS float*)(lds + wave * 16384);
        const int gw = bid * 8 + wave, NGW = G * 8;
        constexpr int I_IN = 4 * 16 * 88, I_OUT = 4 * 16 * 32, I_GU = 4 * 16 * 176, I_DN = 4 * 44 * 32, I_MKV = 4 * 16 * 16;
        constexpr int NITEMS = I_IN + I_OUT + I_GU + I_DN + I_MKV;
        for (int it = gw; it < NITEMS; it += NGW) {
            int r = it;
            if (r < I_IN) {
                const int L = r / 1408; r %= 1408; const int kb = r / 88, nb = r % 88; const bool fox = !(L & 1); const int j = L >> 1;
                const float* W = fox ? p.in[11] + (size_t)j * DM * 2572 : p.in[13] + (size_t)j * DM * 2560; const int ldw = fox ? 2572 : 2560;
                const int n0 = nb * 32; int srccol, nvalid = 32;
                if (n0 < 2304) srccol = n0;
                else if (n0 < 2560) srccol = (fox ? 2316 : 2304) + (n0 - 2304);
                else { if (!fox) continue; if (nb == 80) { srccol = 2304; nvalid = 12; } else { srccol = 0; nvalid = 0; } }
                tr_item(W + (size_t)kb * 64 * ldw + srccol, ldw, p.in[10] + L * DM + kb * 64, WSP(bf16_t, WS_WIN) + (size_t)L * NIN_PAD * DM + (size_t)n0 * DM + kb * 64, DM, nvalid, scr, lane);
                continue;
            }
            r -= I_IN;
            if (r < I_OUT) {
                const int L = r / 512; r %= 512; const int kb = r / 32, nb = r % 32;
                tr_item(p.in[16] + (size_t)L * DM * DM + (size_t)kb * 64 * DM + nb * 32, DM, nullptr, WSP(bf16_t, WS_WOUT) + (size_t)L * DM * DM + (size_t)nb * 32 * DM + kb * 64, DM, 32, scr, lane);
                continue;
            }
            r -= I_OUT;
            if (r < I_GU) {
                const int L = r / 2816; r %= 2816; const int kb = r / 176, nb = r % 176; const int pn = nb >> 3, bj = (nb & 7) >> 2, cb = nb & 3;
                const int srccol = bj * DFF + pn * 128 + cb * 32;
                tr_item(p.in[18] + (size_t)L * DM * 2 * DFF + (size_t)kb * 64 * 2 * DFF + srccol, 2 * DFF, p.in[17] + L * DM + kb * 64, WSP(bf16_t, WS_WGU) + (size_t)L * 2 * DFF * DM + (size_t)nb * 32 * DM + kb * 64, DM, 32, scr, lane);
                continue;
            }
            r -= I_GU;
            if (r < I_DN) {
                const int L = r / 1408; r %= 1408; const int kb = r / 32, nb = r % 32;
                tr_item(p.in[19] + (size_t)L * DFF * DM + (size_t)kb * 64 * DM + nb * 32, DM, nullptr, WSP(bf16_t, WS_WDN) + (size_t)L * DM * DFF + (size_t)nb * 32 * DFF + kb * 64, DFF, 32, scr, lane);
                continue;
            }
            r -= I_DN;
            {
                const int L = r / 256; r %= 256; const int kb = r / 16, nb = r % 16;
                tr_item(p.in[15] + (size_t)L * DM * 512 + (size_t)kb * 64 * 512 + nb * 32, 512, p.in[14] + L * DM + kb * 64, WSP(bf16_t, WS_WMKV) + (size_t)L * 512 * DM + (size_t)nb * 32 * DM + kb * 64, DM, 32, scr, lane);
            }
        }
        for (int rowa = gw; rowa < MTOT + NB * NMEM; rowa += 2 * NGW) {
            f32x4 v[2][4]; const float* src[2]; bf16_t* dst[2]; bool ok[2], ismem[2]; int rw[2];
#pragma unroll
            for (int q = 0; q < 2; ++q) { const int row = rowa + q * NGW; rw[q] = row; ok[q] = row < MTOT + NB * NMEM; ismem[q] = row >= MTOT;
                src[q] = ismem[q] ? p.in[2] + (size_t)(row - MTOT) * DM : (row < MP ? p.in[0] + (size_t)row * DM : p.in[1] + (size_t)(row - MP) * DM);
                dst[q] = ismem[q] ? WSP(bf16_t, WS_MPB) + (size_t)(row - MTOT) * DM : WSP(bf16_t, WS_XB) + (size_t)row * DM;
#pragma unroll
                for (int j = 0; j < 4; ++j) v[q][j] = ok[q] ? *(const f32x4*)(src[q] + j * 256 + lane * 4) : (f32x4){0.f, 0.f, 0.f, 0.f}; }
#pragma unroll
            for (int q = 0; q < 2; ++q) if (ok[q]) {
                float ss = 0.f;
#pragma unroll
                for (int j = 0; j < 4; ++j) { const f32x4 w = v[q][j]; ss += (w[0] * w[0] + w[1] * w[1]) + (w[2] * w[2] + w[3] * w[3]); *(u32x2*)(dst[q] + j * 256 + lane * 4) = pack4(w); }
                ss = wave_sum(ss);
                if (ismem[q]) { if (lane == 0) WSP(float, WS_RSTDM)[rw[q] - MTOT] = rsqrtf(ss * (1.0f / DM) + EPS); }
                else if (lane < 16) WSP(float, WS_SSQA)[(size_t)rw[q] * 16 + lane] = (lane == 0) ? ss : 0.f;
            }
        }
        __syncthreads();
    }
    SEAM(0);

#pragma unroll 1
    for (int L = 0; L < 4; ++L) {
        const bool fox = !(L & 1); const int j = L >> 1; const int P0 = 1 + 5 * L;
        if (IN(P0) && !NO_PIN) {
            const int N = fox ? NIN_PAD : 2560;
            { pg8::Gemm g{WSP(bf16_t, WS_XB), WSP(bf16_t, WS_WIN) + (size_t)L * NIN_PAD * DM, MTOT, N, DM}; pg8::StaticOrder S; S.init(MTOT, N, G, bid);
              EpiIn E{p.ws, p.out, p.in[12] + j * NH, fox ? 1 : 0, j};
              if (DUP & 2) pg8::gemm_phase<EpiIn, pg8::StaticOrder, true, SP2V>(lds, g, S, E);
              pg8::gemm_phase<EpiIn, pg8::StaticOrder, true, SP2V>(lds, g, S, E); }
            if (L < 2) {
                const int nl = (L == 0) ? 1 : 3, l0 = (L == 0) ? 0 : 1; const int rot = ((MTOT / 256) * (N / 256)) % G;
                pg8::Gemm g{WSP(bf16_t, WS_MPB), WSP(bf16_t, WS_WMKV) + (size_t)l0 * 512 * DM, NB * NMEM, nl * 512, DM}; pg8::StaticOrder S; S.init(NB * NMEM, nl * 512, G, (bid + G - rot) % G);
                EpiMKV E{p.ws, p.out, l0};
                pg8::gemm_phase<EpiMKV, pg8::StaticOrder, true, SP2V>(lds, g, S, E);
            }
        }
        SEAM(P0);
        if (IN(P0 + 1) && !NO_ATT) {
            LAS float* c2 = (LAS float*)(lds + A_C2); LAS float* scan = (LAS float*)(lds + A_SCAN); volatile LAS int* su = (volatile LAS int*)(lds + A_UNIT);
            constexpr int U_S = NB * NH, U_P = NB * NH * 8, U_MP = NB * NMH * 8, U_MS = NB * NMH, U_TOT = U_S + U_P + U_MP + U_MS;
            float* out = p.out;
            float* ok_s = out + (fox ? O_FKS : O_SKS) + (size_t)j * KVS_L; float* ov_s = out + (fox ? O_FVS : O_SVS) + (size_t)j * KVS_L;
            float* olf_p = out + O_FLP + (size_t)j * MP * NH; float* olf_s = out + O_FLS + (size_t)j * MS * NH;
            bf16_t* OB = WSP(bf16_t, WS_OB);
            for (int rep = 0; rep < ((DUP & 4) ? 2 : 1); ++rep) {
            for (;;) {
                if (tid == 0) su[0] = (int)atomicAdd(WSP(unsigned, WS_CTR) + L + 4 * rep, 1u);
                __syncthreads();
                const int un = su[0];
                __syncthreads();
                if (un >= U_TOT) break;
                if (un < U_S) {
                    const int bh = un, b = bh / NH, h = bh % NH;
                    const float* K1 = (fox ? p.in[3] : p.in[6]) + (size_t)j * NB * PAST * MIXW + (size_t)b * PAST * MIXW + h * HD;
                    const float* V1 = (fox ? p.in[4] : p.in[7]) + (size_t)j * NB * PAST * MIXW + (size_t)b * PAST * MIXW + h * HD;
                    const float* K2 = ok_s + (size_t)b * DSEQ * MIXW + h * HD; const float* V2 = ov_s + (size_t)b * DSEQ * MIXW + h * HD;
                    bf16_t* O = OB + (size_t)(MP + b * DSEQ) * DM + h * HD;
                    const bf16_t* Q = WSP(bf16_t, WS_QHS) + (size_t)bh * DSEQ * HD;
                    if (fox) {
                        float n2 = 0.f;
                        { const float* kr = K2 + (size_t)(tid & 63) * MIXW;
#pragma unroll
                          for (int i = 0; i < 16; ++i) { const f32x4 v = *(const f32x4*)(kr + i * 4); n2 += (v[0] * v[0] + v[1] * v[1]) + (v[2] * v[2] + v[3] * v[3]); }
#pragma unroll
                          for (int o_ = 1; o_ < 64; o_ <<= 1) n2 = fmaxf(n2, __shfl_xor(n2, o_)); }
                        { float mx = 0.f;
#pragma unroll 1
                          for (int r0 = 0; r0 < PAST; r0 += 32 * 16) {
                              f32x4 kv[16];
#pragma unroll
                              for (int i = 0; i < 16; ++i) kv[i] = *(const f32x4*)(K1 + (size_t)(r0 + i * 32 + (tid >> 4)) * MIXW + (tid & 15) * 4);
#pragma unroll
                              for (int i = 0; i < 16; ++i) { float q2 = (kv[i][0] * kv[i][0] + kv[i][1] * kv[i][1]) + (kv[i][2] * kv[i][2] + kv[i][3] * kv[i][3]);
                                  q2 += __shfl_xor(q2, 1); q2 += __shfl_xor(q2, 2); q2 += __shfl_xor(q2, 4); q2 += __shfl_xor(q2, 8); mx = fmaxf(mx, q2); }
                          }
#pragma unroll
                          for (int o_ = 16; o_ < 64; o_ <<= 1) mx = fmaxf(mx, __shfl_xor(mx, o_));
                          if ((tid & 63) == 0) scan[tid >> 6] = mx;
                          __syncthreads();
                          float m8 = scan[0];
#pragma unroll
                          for (int w = 1; w < 8; ++w) m8 = fmaxf(m8, scan[w]);
                          __syncthreads();
                          n2 = fmaxf(n2, m8); }
                        const float kmax = sqrtf(n2) * 1.01f;
                        attn_unit<false, true>(lds, Q, DSEQ, PAST, K1, V1, MIXW, K2, V2, PAST, (PAST + DSEQ) / 64, true, c2, O, kmax,
                                               p.in[5] + (size_t)j * NB * PAST * NH + (size_t)b * PAST * NH + h, PAST, olf_s + (size_t)b * DSEQ * NH + h, PAST + DSEQ); }
                    else attn_unit<true, true>(lds, Q, DSEQ, PAST, K1, V1, MIXW, K2, V2, PAST, (PAST + DSEQ) / 64, true, nullptr, O, -1.f);
                } else if (un < U_S + U_P) {
                    const int k = un - U_S, qt = 7 - k / (NB * NH), bh = k % (NB * NH), b = bh / NH, h = bh % NH;
                    const bf16_t* Q = WSP(bf16_t, WS_QHP) + ((size_t)bh * SEQ + qt * 256) * HD; const bf16_t* K1 = WSP(bf16_t, WS_KH) + (size_t)bh * SEQ * HD; const bf16_t* V1 = WSP(bf16_t, WS_VT) + (size_t)bh * SEQ * HD;
                    bf16_t* O = OB + (size_t)(b * SEQ + qt * 256) * DM + h * HD;
                    if (fox) {
                        const unsigned* kq = WSP(unsigned, WS_KNMAX) + ((size_t)j * NB * NH + bh) * 2;
                        const float kmax = sqrtf(__uint_as_float(kq[0]) + __uint_as_float(kq[1])) * 1.01f;
                        attn_unit<false, false>(lds, Q, 256, qt * 256, K1, V1, SEQ, nullptr, nullptr, 1 << 30, 4 * (qt + 1), true, c2, O, kmax, olf_p + (size_t)b * SEQ * NH + h, 1 << 30, nullptr, 256 * (qt + 1)); }
                    else attn_unit<true, false>(lds, Q, 256, qt * 256, K1, V1, SEQ, nullptr, nullptr, 1 << 30, 4 * (qt + 1), true, nullptr, O, -1.f);
                } else if (un < U_S + U_P + U_MP) {
                    const int k = un - U_S - U_P, bm = k >> 3, qt = k & 7, b = bm >> 2, mh = bm & 3;
                    attn_unit<false, false>(lds, WSP(bf16_t, WS_QMP) + ((size_t)bm * SEQ + qt * 256) * HD, 256, 0, WSP(bf16_t, WS_MKB) + (size_t)(L * NB * NMH + bm) * NMEM * HD, WSP(bf16_t, WS_MVT) + (size_t)(L * NB * NMH + bm) * NMEM * HD, NMEM,
                                            nullptr, nullptr, 1 << 30, NMEM / 64, false, nullptr, OB + (size_t)(b * SEQ + qt * 256) * DM + MIXW + mh * HD, -1.f);
                } else {
                    const int bm = un - U_S - U_P - U_MP, b = bm >> 2, mh = bm & 3;
                    attn_unit<false, true>(lds, WSP(bf16_t, WS_QMS) + (size_t)bm * DSEQ * HD, DSEQ, 0, p.in[8] + ((size_t)(L * NB + b) * NMEM * NMH + mh) * HD, p.in[9] + ((size_t)(L * NB + b) * NMEM * NMH + mh) * HD, NMH * HD,
                                           nullptr, nullptr, 1 << 30, NMEM / 64, false, nullptr, OB + (size_t)(MP + b * DSEQ) * DM + MIXW + mh * HD, -1.f);
                }
            }
            }
        }
        SEAM(P0 + 1);
        if (IN(P0 + 2) && !NO_POUT) {
            pg8::Gemm g{WSP(bf16_t, WS_OB), WSP(bf16_t, WS_WOUT) + (size_t)L * DM * DM, MP, DM, DM}; pg8::StaticOrder S; S.init(MP, DM, G, bid);
            if (DUP & 8) { EpiRes E2{p.ws, WS_DSSQ, WS_DXB}; pg8::gemm_phase<EpiRes, pg8::StaticOrder, true, SP2V>(lds, g, S, E2); }
            EpiRes E{p.ws, WS_SSQB, WS_XB};
            pg8::gemm_phase<EpiRes, pg8::StaticOrder, true, SP2V>(lds, g, S, E);
            for (int tile = bid; tile < 256; tile += G)
                small_res_gemm(lds, WSP(bf16_t, WS_OB) + (size_t)MP * DM, WSP(bf16_t, WS_WOUT) + (size_t)L * DM * DM, DM, WSP(bf16_t, WS_XB) + (size_t)MP * DM, WSP(float, WS_SSQB) + (size_t)MP * 16, tile);
        }
        SEAM(P0 + 2);
        if (IN(P0 + 3) && !NO_PGU) {
            pg8::Gemm g{WSP(bf16_t, WS_XB), WSP(bf16_t, WS_WGU) + (size_t)L * 2 * DFF * DM, MTOT, 2 * DFF, DM}; pg8::StaticOrder S; S.init(MTOT, 2 * DFF, G, bid);
            EpiGU E{p.ws};
            if (DUP & 16) pg8::gemm_phase<EpiGU, pg8::StaticOrder, true, SP2V>(lds, g, S, E);
            pg8::gemm_phase<EpiGU, pg8::StaticOrder, true, SP2V>(lds, g, S, E);
        }
        SEAM(P0 + 3);
        if (IN(P0 + 4) && !NO_PDN) {
            pg8::Gemm g{WSP(bf16_t, WS_ACT), WSP(bf16_t, WS_WDN) + (size_t)L * DM * DFF, MP, DM, DFF}; pg8::StaticOrder S; S.init(MP, DM, G, bid);
            if (DUP & 32) { EpiRes E2{p.ws, WS_DSSQ, WS_DXB}; pg8::gemm_phase<EpiRes, pg8::StaticOrder, true, SP2V>(lds, g, S, E2); }
            EpiRes E{p.ws, WS_SSQA, WS_XB};
            pg8::gemm_phase<EpiRes, pg8::StaticOrder, true, SP2V>(lds, g, S, E);
            for (int tile = bid; tile < 256; tile += G)
                small_res_gemm(lds, WSP(bf16_t, WS_ACT) + (size_t)MP * DFF, WSP(bf16_t, WS_WDN) + (size_t)L * DM * DFF, DFF, WSP(bf16_t, WS_XB) + (size_t)MP * DM, WSP(float, WS_SSQA) + (size_t)MP * 16, tile);
        }
        SEAM(P0 + 4);
    }
    if (IN(21)) {
        const int gw = bid * 8 + wave, NGW = G * 8;
        const bf16_t* XB = WSP(bf16_t, WS_XB); const float* g_final = p.in[20]; float* out = p.out;
        for (int row0 = gw; row0 < MTOT; row0 += 2 * NGW) {
            const int row1 = row0 + NGW; const bool has1 = row1 < MTOT;
            const float rs0 = rstd16(WSP(float, WS_SSQA), row0), rs1 = has1 ? rstd16(WSP(float, WS_SSQA), row1) : 0.f;
            u32x2 x0[4], x1[4];
#pragma unroll
            for (int j = 0; j < 4; ++j) { x0[j] = *(const u32x2*)(XB + (size_t)row0 * DM + j * 256 + lane * 4); x1[j] = has1 ? *(const u32x2*)(XB + (size_t)row1 * DM + j * 256 + lane * 4) : (u32x2){0u, 0u}; }
#pragma unroll
            for (int j = 0; j < 4; ++j) { const int c = j * 256 + lane * 4; const f32x4 gv = *(const f32x4*)(g_final + c);
                *(f32x4*)(out + (size_t)row0 * DM + c) = unpack4(x0[j]) * rs0 * gv;
                if (has1) *(f32x4*)(out + (size_t)row1 * DM + c) = unpack4(x1[j]) * rs1 * gv; }
        }
    }
#undef IN
#undef SEAM
#undef WSP
}

extern "C" void kernel_launch(void* const* d_in, const int* in_sizes, int n_in, void* d_out, int out_size, void* d_ws, size_t ws_size, hipStream_t stream) {
    static int grid = 0;
    if (grid == 0) {
        if (n_in != 21 || (size_t)out_size != O_END || ws_size < (DUP ? WS_DEND : WS_END)) { fprintf(stderr, "kernel_launch: unexpected sizes n_in %d out %d ws %zu (need %zu)\n", n_in, out_size, ws_size, (size_t)WS_END); grid = -1; return; }
        int dev = 0, cus = 0, per_cu = 0;
        hipGetDevice(&dev); hipDeviceGetAttribute(&cus, hipDeviceAttributeMultiprocessorCount, dev);
        if (hipFuncSetAttribute((const void*)mega, hipFuncAttributeMaxDynamicSharedMemorySize, LDS_BYTES) != hipSuccess) { fprintf(stderr, "kernel_launch: hipFuncSetAttribute failed\n"); grid = -1; return; }
        if (hipOccupancyMaxActiveBlocksPerMultiprocessor(&per_cu, (const void*)mega, 512, LDS_BYTES) != hipSuccess || per_cu < 1) { fprintf(stderr, "kernel_launch: occupancy query says %d\n", per_cu); per_cu = 1; }
        (void)hipGetLastError();
        grid = cus * 1;
    }
    if (grid < 0) return;
    Params p{};
    for (int i = 0; i < 21; ++i) p.in[i] = (const float*)d_in[i];
    p.out = (float*)d_out; p.ws = (unsigned char*)d_ws;
#if ONE_LAUNCH
    if (hipMemsetAsync((char*)d_ws + WS_KNMAX, 0, (WS_BAR - WS_KNMAX) + 16384, stream) != hipSuccess) { fprintf(stderr, "kernel_launch: memset failed\n"); return; }
    p.ph_lo = 0; p.ph_hi = N_PHASES;
    void* args[] = {&p};
    hipError_t e = hipLaunchCooperativeKernel((void*)mega, dim3(grid), dim3(512), args, LDS_BYTES, stream);
    if (e != hipSuccess) fprintf(stderr, "cooperative launch failed: %s (grid %d)\n", hipGetErrorString(e), grid);
#else
    for (int ph = 0; ph < N_PHASES; ++ph) {
        p.ph_lo = ph; p.ph_hi = ph + 1;
        hipLaunchKernelGGL(mega, dim3(grid), dim3(512), LDS_BYTES, stream, p);
    }
#endif
}
```
